# Optimizing an MI355X kernel written in HIP

```python
import math
import jax, jax.numpy as jnp
from jax import lax
import numpy as np


D_MODEL = 1024
BATCH = 8
SEQ = 8192
DEPTH = 4

MLSTM_HEADS = 4
MLSTM_QK_DIM = 64
MLSTM_V_DIM = 128
MLSTM_CONV = 4
MLSTM_CHUNK = 64
DSA_HEADS = 8
DSA_HEAD_DIM = 64
DSA_LATENT = 128
IDX_HEADS = 8
IDX_DIM = 32
IDX_TOPK_MAX = 256
QUERY_BLOCK = 128
REL_BUCKETS = 32
REL_MAX_DIST = 128
D_FF = 2816
N_EXPERTS = 8
TOP_K = 2
D_FF_EXPERT = 3584
MOE_BLOCK = 256
N_DENSE = (DEPTH + 1) // 2
N_MOE = DEPTH // 2
DN_ALPHA = (2 * DEPTH) ** 0.25
DN_BETA = (8 * DEPTH) ** -0.25
LN_EPS = 1e-5

A_QK = 2 * MLSTM_HEADS * MLSTM_QK_DIM
A_V = MLSTM_HEADS * MLSTM_V_DIM
A_GATE = 2 * MLSTM_HEADS
B_Q = DSA_HEADS * DSA_HEAD_DIM
I_Q = IDX_HEADS * IDX_DIM
PROJ_SIZES = (A_QK, A_V, A_V, A_GATE, B_Q, DSA_LATENT, I_Q, IDX_DIM, IDX_HEADS, D_MODEL, D_MODEL)
D_IN_PROJ = sum(PROJ_SIZES)

kernel_name = 'hybrid_mlstm_dsa_moe_deepnorm'


def layer_norm(x, g, b):
    xf = x.astype(jnp.float32)
    mu = jnp.mean(xf, -1, keepdims=True)
    var = jnp.mean(jnp.square(xf - mu), -1, keepdims=True)
    return ((xf - mu) * lax.rsqrt(var + LN_EPS)).astype(x.dtype) * g + b


def rms_norm(x, g):
    xf = x.astype(jnp.float32)
    return (xf * lax.rsqrt(jnp.mean(jnp.square(xf), -1, keepdims=True) + LN_EPS)).astype(x.dtype) * g


def causal_depthwise_conv(u, w):
    taps, s = w.shape[0], u.shape[1]
    up = jnp.pad(u, ((0, 0), (taps - 1, 0), (0, 0)))
    return sum(up[:, j:j + s] * w[j] for j in range(taps))


def mlstm_chunkwise(q, k, v, i_pre, log_f):
    bsz, s, h, dk = q.shape
    dv = v.shape[-1]
    ch = MLSTM_CHUNK
    nc = s // ch
    to_c = lambda a: a.reshape(bsz, nc, ch, h, -1).transpose(1, 0, 3, 2, 4)
    to_cg = lambda a: a.reshape(bsz, nc, ch, h).transpose(1, 0, 3, 2)
    causal = jnp.tril(jnp.ones((ch, ch), dtype=bool))

    def step(carry, inp):
        c_st, n_st, m_st = carry
        qc, kc, vc, ic, fc = inp
        b = jnp.cumsum(fc, axis=-1)
        d_log = jnp.where(causal, b[..., :, None] - b[..., None, :] + ic[..., None, :], -jnp.inf)
        inter = b + m_st[..., None]
        m_t = jnp.maximum(inter, jnp.max(d_log, -1))
        s_w = jnp.einsum('bhtd,bhsd->bhts', qc, kc) * jnp.exp(d_log - m_t[..., None])
        inter_w = jnp.exp(inter - m_t)
        num = jnp.einsum('bhts,bhsv->bhtv', s_w, vc) + inter_w[..., None] * jnp.einsum('bhtd,bhdv->bhtv', qc, c_st)
        den = jnp.sum(s_w, -1) + inter_w * jnp.einsum('bhtd,bhd->bht', qc, n_st)
        h_out = num / jnp.maximum(jnp.abs(den), jnp.exp(-m_t))[..., None]
        b_last = b[..., -1]
        g_log = b_last[..., None] - b + ic
        m_new = jnp.maximum(b_last + m_st, jnp.max(g_log, -1))
        decay = jnp.exp(b_last + m_st - m_new)
        w_k = kc * jnp.exp(g_log - m_new[..., None])[..., None]
        c_new = decay[..., None, None] * c_st + jnp.einsum('bhsd,bhsv->bhdv', w_k, vc)
        n_new = decay[..., None] * n_st + jnp.sum(w_k, -2)
        return (c_new, n_new, m_new), h_out

    init = (jnp.zeros((bsz, h, dk, dv), jnp.float32), jnp.zeros((bsz, h, dk), jnp.float32),
            jnp.zeros((bsz, h), jnp.float32))
    _, hs = lax.scan(step, init, (to_c(q), to_c(k), to_c(v), to_cg(i_pre), to_cg(log_f)))
    return hs.transpose(1, 0, 3, 2, 4).reshape(bsz, s, h, dv)


def t5_bucket(dist):
    dist = jnp.maximum(dist, 0)
    exact = REL_BUCKETS // 2
    log_ratio = jnp.log(jnp.maximum(dist, 1).astype(jnp.float32) / exact) / math.log(REL_MAX_DIST / exact)
    large = jnp.minimum(exact + (log_ratio * (REL_BUCKETS - exact)).astype(jnp.int32), REL_BUCKETS - 1)
    return jnp.where(dist < exact, dist, large)


def dsa_sparse_attention(q_lat, c_kv, q_idx, k_idx, w_idx, rel_bias):
    bsz, s, h, dc = q_lat.shape
    nb = s // QUERY_BLOCK
    topk = min(IDX_TOPK_MAX, s // 4)
    scale = DSA_HEAD_DIM ** -0.5
    spos = jnp.arange(s)
    blocks = lambda a: a.reshape((bsz, nb, QUERY_BLOCK) + a.shape[2:]).swapaxes(0, 1)

    def one_block(args):
        ql, qi, wi, t0 = args
        tpos = t0 + jnp.arange(QUERY_BLOCK)
        score = jnp.einsum('bqhs,bqh->bqs', jax.nn.relu(jnp.einsum('bqhd,bsd->bqhs', qi, k_idx)), wi)
        score = jnp.where(spos[None, None, :] <= tpos[None, :, None], score.astype(jnp.float32), -jnp.inf)
        _, idx = lax.top_k(score, topk)
        valid = idx <= tpos[None, :, None]
        c_sel = jax.vmap(lambda cb, ib: cb[ib])(c_kv, idx)
        logits = jnp.einsum('bqhc,bqkc->bqhk', ql, c_sel).astype(jnp.float32) * scale
        bias = rel_bias[t5_bucket(tpos[None, :, None] - idx)].transpose(0, 1, 3, 2)
        logits = jnp.where(valid[:, :, None, :], logits + bias.astype(jnp.float32), -jnp.inf)
        p = jax.nn.softmax(logits, axis=-1).astype(c_sel.dtype)
        return jnp.einsum('bqhk,bqkc->bqhc', p, c_sel)

    out = lax.map(one_block, (blocks(q_lat), blocks(q_idx), blocks(w_idx), jnp.arange(nb) * QUERY_BLOCK))
    return out.swapaxes(0, 1).reshape(bsz, s, h, dc)


def token_mixer(x, w_in, conv_w, gate_bias, norm_g, kv_norm_g, w_uk, w_uv, rel_bias,
                w_branch_a, w_branch_b, w_out):
    bsz, s, _ = x.shape
    offsets = np.cumsum(PROJ_SIZES)[:-1].tolist()
    a_qk, a_v, a_o, a_if, b_q, b_c, i_q, i_k, i_w, g_a, g_b = jnp.split(x @ w_in, offsets, axis=-1)
    qk = jax.nn.silu(causal_depthwise_conv(a_qk, conv_w)).astype(jnp.float32)
    q, k = jnp.split(qk.reshape(bsz, s, 2 * MLSTM_HEADS, MLSTM_QK_DIM), 2, axis=2)
    k = k * MLSTM_QK_DIM ** -0.5
    v = a_v.astype(jnp.float32).reshape(bsz, s, MLSTM_HEADS, MLSTM_V_DIM)
    gates = a_if.astype(jnp.float32).reshape(bsz, s, 2, MLSTM_HEADS) + gate_bias
    h = mlstm_chunkwise(q, k, v, gates[:, :, 0], jax.nn.log_sigmoid(gates[:, :, 1]))
    mu = jnp.mean(h, -1, keepdims=True)
    h = (h - mu) * lax.rsqrt(jnp.mean(jnp.square(h - mu), -1, keepdims=True) + LN_EPS)
    y_a = h.reshape(bsz, s, A_V).astype(x.dtype) * norm_g * jax.nn.sigmoid(a_o)
    q_lat = jnp.einsum('bshd,hdc->bshc', b_q.reshape(bsz, s, DSA_HEADS, DSA_HEAD_DIM), w_uk)
    c_kv = rms_norm(b_c, kv_norm_g)
    w_idx = i_w * (IDX_HEADS * IDX_DIM) ** -0.5
    o_lat = dsa_sparse_attention(q_lat, c_kv, i_q.reshape(bsz, s, IDX_HEADS, IDX_DIM), i_k, w_idx, rel_bias)
    y_b = jnp.einsum('bshc,hcd->bshd', o_lat, w_uv).reshape(bsz, s, B_Q)
    merged = jax.nn.sigmoid(g_a) * (y_a @ w_branch_a) + jax.nn.sigmoid(g_b) * (y_b @ w_branch_b)
    return merged @ w_out


def swiglu(x, wg, wu, wd):
    return (jax.nn.silu(x @ wg) * (x @ wu)) @ wd


def moe_swiglu(x2, router_w, wg, wu, wd):
    n, d = x2.shape
    logits = (x2 @ router_w).astype(jnp.float32)
    top_logit, top_e = lax.top_k(logits, TOP_K)
    gates = jax.nn.softmax(top_logit, axis=-1)
    flat_e = top_e.reshape(-1)
    flat_tok = jnp.repeat(jnp.arange(n, dtype=jnp.int32), TOP_K)
    flat_g = gates.reshape(-1)
    order = jnp.argsort(flat_e, stable=True)
    se, stok, sg = flat_e[order], flat_tok[order], flat_g[order]
    counts = jnp.bincount(flat_e, length=N_EXPERTS)
    starts = jnp.cumsum(counts) - counts
    padded = ((counts + MOE_BLOCK - 1) // MOE_BLOCK) * MOE_BLOCK
    pad_end = jnp.cumsum(padded)
    pad_start = pad_end - padded
    dest = pad_start[se] + (jnp.arange(n * TOP_K) - starts[se])
    total = n * TOP_K + N_EXPERTS * MOE_BLOCK
    nblk = total // MOE_BLOCK
    buf_tok = jnp.zeros((total,), jnp.int32).at[dest].set(stok)
    buf_g = jnp.zeros((total,), jnp.float32).at[dest].set(sg)
    blk_e = jnp.minimum(jnp.searchsorted(pad_end, jnp.arange(nblk) * MOE_BLOCK, side='right'), N_EXPERTS - 1)

    def run(args):
        tok, g, e = args
        xb = x2[tok]
        hb = jax.nn.silu(xb @ wg[e]) * (xb @ wu[e])
        return (hb @ wd[e]) * g[:, None].astype(x2.dtype)

    y = lax.map(run, (buf_tok.reshape(nblk, MOE_BLOCK), buf_g.reshape(nblk, MOE_BLOCK), blk_e))
    return jnp.zeros_like(x2).at[buf_tok].add(y.reshape(total, d))


def setup_inputs(seed: int = 0) -> dict:
    key = jax.random.key(seed)
    ks = jax.random.split(key, 24)
    nrm = lambda k, shape, sc: jax.random.normal(k, shape, jnp.float32) * sc
    D = D_MODEL
    gate_bias = jnp.stack([nrm(ks[3], (DEPTH, MLSTM_HEADS), 0.1),
                           3.0 + nrm(ks[4], (DEPTH, MLSTM_HEADS), 0.5)], axis=1)
    return {
        'x': nrm(ks[0], (BATCH, SEQ, D), 1.0),
        'w_in': nrm(ks[1], (DEPTH, D, D_IN_PROJ), D ** -0.5),
        'mlstm_conv_w': nrm(ks[2], (DEPTH, MLSTM_CONV, A_QK), MLSTM_CONV ** -0.5),
        'mlstm_gate_bias': gate_bias,
        'mlstm_norm_g': 1.0 + nrm(ks[5], (DEPTH, A_V), 0.02),
        'dsa_kv_norm_g': 1.0 + nrm(ks[6], (DEPTH, DSA_LATENT), 0.02),
        'dsa_w_uk': nrm(ks[7], (DEPTH, DSA_HEADS, DSA_HEAD_DIM, DSA_LATENT), DSA_HEAD_DIM ** -0.5),
        'dsa_w_uv': nrm(ks[8], (DEPTH, DSA_HEADS, DSA_LATENT, DSA_HEAD_DIM), DSA_LATENT ** -0.5),
        'rel_bias': nrm(ks[9], (REL_BUCKETS, DSA_HEADS), 0.5),
        'w_branch_a': nrm(ks[10], (DEPTH, A_V, D), A_V ** -0.5 * DN_BETA),
        'w_branch_b': nrm(ks[11], (DEPTH, B_Q, D), B_Q ** -0.5 * DN_BETA),
        'w_out': nrm(ks[12], (DEPTH, D, D), D ** -0.5 * DN_BETA),
        'ln_g': 1.0 + nrm(ks[13], (DEPTH, 2, D), 0.02),
        'ln_b': nrm(ks[14], (DEPTH, 2, D), 0.02),
        'dense_w_gate': nrm(ks[15], (N_DENSE, D, D_FF), D ** -0.5),
        'dense_w_up': nrm(ks[16], (N_DENSE, D, D_FF), D ** -0.5),
        'dense_w_down': nrm(ks[17], (N_DENSE, D_FF, D), D_FF ** -0.5 * DN_BETA),
        'router_w': nrm(ks[18], (N_MOE, D, N_EXPERTS), D ** -0.5),
        'expert_w_gate': nrm(ks[19], (N_MOE, N_EXPERTS, D, D_FF_EXPERT), D ** -0.5),
        'expert_w_up': nrm(ks[20], (N_MOE, N_EXPERTS, D, D_FF_EXPERT), D ** -0.5),
        'expert_w_down': nrm(ks[21], (N_MOE, N_EXPERTS, D_FF_EXPERT, D), D_FF_EXPERT ** -0.5 * DN_BETA),
    }


def reference(x, w_in, mlstm_conv_w, mlstm_gate_bias, mlstm_norm_g, dsa_kv_norm_g, dsa_w_uk, dsa_w_uv,
              rel_bias, w_branch_a, w_branch_b, w_out, ln_g, ln_b, dense_w_gate, dense_w_up, dense_w_down,
              router_w, expert_w_gate, expert_w_up, expert_w_down):
    for l in range(DEPTH):
        mix = token_mixer(x, w_in[l], mlstm_conv_w[l], mlstm_gate_bias[l], mlstm_norm_g[l], dsa_kv_norm_g[l],
                          dsa_w_uk[l], dsa_w_uv[l], rel_bias, w_branch_a[l], w_branch_b[l], w_out[l])
        x = layer_norm(DN_ALPHA * x + mix, ln_g[l, 0], ln_b[l, 0])
        if l % 2 == 0:
            f = swiglu(x, dense_w_gate[l // 2], dense_w_up[l // 2], dense_w_down[l // 2])
        else:
            j = l // 2
            f = moe_swiglu(x.reshape(-1, x.shape[-1]), router_w[j], expert_w_gate[j], expert_w_up[j],
                           expert_w_down[j]).reshape(x.shape)
        x = layer_norm(DN_ALPHA * x + f, ln_g[l, 1], ln_b[l, 1])
    return x
```

```cpp
#include <hip/hip_runtime.h>
#include <cstdio>
#include <cstdint>

#ifndef MK_ONE_LAUNCH
#define MK_ONE_LAUNCH 1
#endif

#ifndef EXP_ZERO_DSA
#define EXP_ZERO_DSA 0
#endif
#ifndef EXP_ZERO_MLSTM
#define EXP_ZERO_MLSTM 0
#endif
#define LAS __attribute__((address_space(3)))
typedef unsigned short bf16_t;
typedef short bf16x8 __attribute__((ext_vector_type(8)));
typedef float f32x4 __attribute__((ext_vector_type(4)));
typedef float f32x16 __attribute__((ext_vector_type(16)));
typedef unsigned u32x4 __attribute__((ext_vector_type(4)));
typedef unsigned u32x2 __attribute__((ext_vector_type(2)));

constexpr int D = 1024, BATCH = 8, SEQ = 8192, DEPTH = 4;
constexpr int MH = 4 * SEQ;
constexpr int NHALF = 2;
constexpr int NP = 5120;
constexpr int C_QK = 0, C_V = 512, C_O = 1024, C_QL = 1536, C_BC = 2560, C_IQ = 2688, C_IK = 2944, C_GA = 2976, C_GB = 4000, C_IF = 5024, C_IW = 5032, C_END = 5040;
constexpr int DIN = 4528;
constexpr int DFF = 2816, DFE = 3584, NEXP = 8;
constexpr float DN_ALPHA = 1.681792830507429f;
constexpr float LN_EPS = 1e-5f;
constexpr int MOE_ROWS = 2 * MH + NEXP * 256;
constexpr int MOE_BLKS = MOE_ROWS / 256;

constexpr size_t MiB = 1u << 20;
constexpr size_t WS_CTL = 0, CTL_BYTES = 1 * MiB;
constexpr size_t WS_MISC = 1 * MiB;
constexpr size_t WS_WMIX = 5 * MiB;
constexpr size_t WMIX_LAYER = 15 * MiB, WM_IN = 0, WM_A = 10 * MiB, WM_OB = 11 * MiB, WM_OUT = 13 * MiB;
constexpr size_t WS_WFFN = 65 * MiB;
constexpr size_t WF_GU_E = (size_t)2 * DFE * D * 2, WF_D_OFF = (size_t)NEXP * WF_GU_E, WF_D_E = (size_t)D * DFE * 2;
constexpr size_t WS_XB = 233 * MiB;
constexpr size_t WS_R0 = 361 * MiB;
constexpr size_t WS_PROJ = WS_R0;
constexpr size_t WS_CKV = 681 * MiB;
constexpr size_t WS_SIDE = 689 * MiB;
constexpr size_t WS_SKV = 691 * MiB;
constexpr size_t WS_SN = 755 * MiB;
constexpr size_t WS_SSC = 756 * MiB;
constexpr size_t WS_IDX = 757 * MiB;
constexpr size_t WS_IKP = 773 * MiB;
constexpr size_t WS_HD = WS_R0;
constexpr size_t WS_XS = WS_R0;
constexpr size_t WS_HM = 493 * MiB;
constexpr size_t WS_END = 955 * MiB;
constexpr size_t MS_TE = 0;
constexpr size_t MS_TG = 256 * 1024;
constexpr size_t MS_TD = 512 * 1024;
constexpr size_t MS_RG = 768 * 1024;
constexpr size_t MS_WGC = 1100 * 1024;
constexpr size_t MS_META = 1200 * 1024;
constexpr int CW_BAR = 4096;

constexpr int LDS_MAIN = 131072;
constexpr int LDS_AUX = LDS_MAIN;
constexpr int LDS_CTLW = LDS_MAIN + 12288;
constexpr int LDS_BYTES = 147456;

__device__ __forceinline__ unsigned f2bf(float f) { unsigned u = __builtin_bit_cast(unsigned, f); return (u + 0x7fffu + ((u >> 16) & 1u)) >> 16; }
__device__ __forceinline__ unsigned pk2(float lo, float hi) { return f2bf(lo) | (f2bf(hi) << 16); }
__device__ __forceinline__ float bf2f(unsigned short b) { return __builtin_bit_cast(float, ((unsigned)b) << 16); }
__device__ __forceinline__ float bflo(unsigned w) { return __builtin_bit_cast(float, w << 16); }
__device__ __forceinline__ float bfhi(unsigned w) { return __builtin_bit_cast(float, w & 0xffff0000u); }
__device__ __forceinline__ unsigned cvt_pk_bf16(float lo, float hi) { unsigned r; asm volatile("v_cvt_pk_bf16_f32 %0, %1, %2" : "=v"(r) : "v"(lo), "v"(hi)); return r; }
__device__ __forceinline__ float sigmoidf_(float x) { return 1.f / (1.f + __expf(-x)); }
__device__ __forceinline__ float wave_sum(float v) {
#pragma unroll
    for (int o = 1; o < 64; o <<= 1) v += __shfl_xor(v, o);
    return v;
}
__device__ __forceinline__ unsigned mbcnt64(unsigned long long m) { return __builtin_amdgcn_mbcnt_hi((unsigned)(m >> 32), __builtin_amdgcn_mbcnt_lo((unsigned)m, 0u)); }
#define LDS_WAIT() asm volatile("s_waitcnt lgkmcnt(0)" ::: "memory")
#define VM_WAIT() asm volatile("s_waitcnt vmcnt(0)" ::: "memory")

#define XB_TMO      128
#define XB_XCNT(j)  (256  + 64 * (j))
#define XB_XSUB(j)  (1280 + 64 * (j))
#define XB_XGEN(j)  (2304 + 64 * (j))
#define XB_TOP      3328
#define XB_TOPGEN   3392
#define XCD_BAR_WORDS 3456
#define XB_SPIN_CAP (1u << 18)
__device__ __forceinline__ unsigned xb_ld(unsigned* p)              { return __hip_atomic_load(p, __ATOMIC_RELAXED, __HIP_MEMORY_SCOPE_AGENT); }
__device__ __forceinline__ unsigned xb_add(unsigned* p, unsigned v) { return __hip_atomic_fetch_add(p, v, __ATOMIC_RELAXED, __HIP_MEMORY_SCOPE_AGENT); }
__device__ __forceinline__ unsigned xb_xcc_id() { return (unsigned)__builtin_amdgcn_s_getreg((3 << 11) | 20) & 0xFu; }
#define XB_SPIN(cond, bar) do { unsigned _sp = 0; while (cond) { __builtin_amdgcn_s_sleep(1); \
    if ((++_sp & 255u) == 0u) { if (xb_ld(&(bar)[XB_TMO])) break; if (_sp > XB_SPIN_CAP) { atomicAdd(&(bar)[XB_TMO], 1u); break; } } } } while (0)
struct XcdBarrier { unsigned* bar; unsigned x; volatile LAS unsigned* st; };
__device__ __forceinline__ XcdBarrier xcd_barrier_post(unsigned* bar, volatile LAS unsigned* st) {
    XcdBarrier b; b.bar = bar; b.x = xb_xcc_id(); b.st = st;
    if (threadIdx.x == 0) (void)xb_add(&bar[XB_XCNT(b.x)], 1u);
    return b;
}
__device__ __forceinline__ void xcd_barrier_complete(unsigned* bar, unsigned x, unsigned& nloc, unsigned& nx) {
    const unsigned G = gridDim.x * gridDim.y * gridDim.z;
    unsigned sum, cnt, mine, sp = 0u;
    for (;;) {
        sum = 0u; cnt = 0u; mine = 0u;
#pragma unroll
        for (unsigned j = 0; j < 16; ++j) { const unsigned c = xb_ld(&bar[XB_XCNT(j)]); sum += c; cnt += (c > 0u) ? 1u : 0u; mine = (j == x) ? c : mine; }
        if (sum == G) break;
        __builtin_amdgcn_s_sleep(1);
        if ((++sp & 255u) == 0u) { if (xb_ld(&bar[XB_TMO])) break; if (sp > XB_SPIN_CAP) { atomicAdd(&bar[XB_TMO], 1u); break; } }
    }
    nloc = mine > 0u ? mine : 1u; nx = cnt > 0u ? cnt : 1u;
}
__device__ __attribute__((noinline)) void xcd_barrier(const XcdBarrier b) {
    asm volatile("s_waitcnt vmcnt(0)" ::: "memory");
    __syncthreads();
    if (threadIdx.x == 0) {
        unsigned* bar = b.bar;
        __builtin_amdgcn_s_waitcnt(0);
        unsigned nloc = b.st[0], nx = b.st[1];
        if (nloc == 0u) { xcd_barrier_complete(bar, b.x, nloc, nx); b.st[0] = nloc; b.st[1] = nx; }
        const unsigned old = xb_add(&bar[XB_XSUB(b.x)], 1u);
        const unsigned gen = old / nloc;
        if (old + 1u == (gen + 1u) * nloc) {
            __builtin_amdgcn_fence(__ATOMIC_RELEASE, "agent");
            asm volatile("s_waitcnt vmcnt(0)" ::: "memory");
            const unsigned og = xb_add(&bar[XB_TOP], 1u);
            const unsigned tg = og / nx;
            if (og + 1u == (tg + 1u) * nx) xb_add(&bar[XB_TOPGEN], 1u);
            else XB_SPIN(xb_ld(&bar[XB_TOPGEN]) == tg, bar);
            __builtin_amdgcn_fence(__ATOMIC_ACQUIRE, "agent");
            xb_add(&bar[XB_XGEN(b.x)], 1u);
            asm volatile("s_waitcnt vmcnt(0)" ::: "memory");
        } else {
            XB_SPIN(xb_ld(&bar[XB_XGEN(b.x)]) == gen, bar);
            __builtin_amdgcn_fence(__ATOMIC_ACQUIRE, "agent");
            asm volatile("s_waitcnt vmcnt(0)" ::: "memory");
        }
    }
    __syncthreads();
}

namespace pg8 {
constexpr int BM = 256, BK = 64, HALF = 128, HTB = HALF * BK * 2, STAGE_BYTES = 8 * HTB, NXCD = 8, WGM = 8;
__host__ __device__ __forceinline__ int lds_byte(int r, int c) { const int st = (r >> 4) * 2 + (c >> 5), rr = r & 15, cc = c & 31, ob = rr * 64 + cc * 2; return st * 1024 + (ob ^ (((ob >> 9) & 1) << 5)); }
__host__ __device__ __forceinline__ void stage_rc(int b, int& R, int& C) { const int st = b / 1024, sb = b % 1024, swz = sb ^ (((sb >> 9) & 1) << 5); R = (st >> 1) * 16 + swz / 64; C = (st & 1) * 32 + (swz % 64) / 2; }
__host__ __device__ __forceinline__ int perm32(int rho) { const int n = rho >> 4, i = rho & 15; return 8 * (i >> 2) + 4 * n + (i & 3); }
struct Unit { int pm, pn; };
struct Gemm { const bf16_t* A; const bf16_t* Bt; int lda, ldb, K; };
struct Order {
    int nM, nN, nwg, G, c; const unsigned* blk_e; size_t b_estride; size_t a_tstep, b_tstep;
    __device__ void init(int nM_, int nN_, int G_, int c_, const Gemm& g, const unsigned* be = nullptr, size_t bes = 0) {
        nM = nM_; nN = nN_; nwg = nM * nN; G = G_; c = c_; blk_e = be; b_estride = bes; a_tstep = (size_t)BM * g.lda * 2; b_tstep = (size_t)BM * g.ldb * 2; }
    __device__ bool next(int i, Unit& u) const {
        const long L = (long)i * G + c; if (L >= nwg) return false;
        int wgid = (int)L; { const int q = nwg / NXCD, r = nwg % NXCD, xcd = wgid % NXCD, off = wgid / NXCD; wgid = (xcd < r ? xcd * (q + 1) : r * (q + 1) + (xcd - r) * q) + off; }
        const int nig = WGM * nN, gid = wgid / nig, fm = gid * WGM, gsz = (nM - fm) < WGM ? (nM - fm) : WGM;
        u.pm = fm + ((wgid % nig) % gsz); u.pn = (wgid % nig) / gsz; return true;
    }
    __device__ __forceinline__ size_t a_off(const Unit& u) const { return (size_t)u.pm * a_tstep; }
    __device__ __forceinline__ size_t b_off(const Unit& u) const { size_t o = (size_t)u.pn * b_tstep; if (blk_e) o += (size_t)__builtin_amdgcn_readfirstlane(blk_e[u.pm]) * b_estride; return o; }
};

template <class Epi>
__device__ __forceinline__ void gemm_phase(LAS unsigned char* lds, const Gemm g, const Order& S, const Epi& E, const int tid) {
    const int wid = __builtin_amdgcn_readfirstlane(tid >> 6), lane = tid & 63, wr = wid >> 2, wc = wid & 3, fr = lane & 15, fq = lane >> 4;
    const int K = g.K, nt = K / BK;
    unsigned voffA[2], voffB[2];
#pragma unroll
    for (int i = 0; i < 2; ++i) { int R, C; stage_rc(tid * 16 + i * 8192, R, C); const int Rb = Epi::PERM ? ((R & ~31) + perm32(R & 31)) : R;
        voffA[i] = (unsigned)(R * g.lda + C) * 2u; voffB[i] = (unsigned)(Rb * g.ldb + C) * 2u; }
    const size_t kstep = (size_t)(BK * 2);
    const size_t hstepA = (size_t)HALF * g.lda * 2, hstepB = (size_t)HALF * g.ldb * 2;
    const unsigned ldsw = (unsigned)wid * 1024u;
    const int aoff = lds_byte(wr * 64 + fr, fq * 8), boff = lds_byte(wc * 32 + fr, fq * 8);
#define PG8_SA(b, h) (((b) * 2 + (h)) * HTB)
#define PG8_SB(b, h) ((4 + (b) * 2 + (h)) * HTB)
#define PG8_STAGE(bufoff, gbase, voff) do { _Pragma("unroll") for (int _i = 0; _i < 2; ++_i) \
        __builtin_amdgcn_global_load_lds((const unsigned*)((const char*)(gbase) + (voff)[_i]), (LAS unsigned*)(lds + (bufoff) + ldsw + _i * 8192), 16, 0, 0); } while (0)
#define PG8_LDA(dst, b, h) do { _Pragma("unroll") for (int m = 0; m < 4; ++m) _Pragma("unroll") for (int k = 0; k < 2; ++k) dst[m][k] = *(const LAS bf16x8*)(lds + PG8_SA(b, h) + aoff + m * 2048 + k * 1024); } while (0)
#define PG8_LDB(dst, b, h) do { _Pragma("unroll") for (int n = 0; n < 2; ++n) _Pragma("unroll") for (int k = 0; k < 2; ++k) dst[n][k] = *(const LAS bf16x8*)(lds + PG8_SB(b, h) + boff + n * 2048 + k * 1024); } while (0)
#define PG8_MMA(ai, bj, At, Bt) do { __builtin_amdgcn_s_setprio(1); _Pragma("unroll") for (int m = 0; m < 4; ++m) _Pragma("unroll") for (int n = 0; n < 2; ++n) _Pragma("unroll") for (int k = 0; k < 2; ++k) \
        acc[ai][bj][m][n] = __builtin_amdgcn_mfma_f32_16x16x32_bf16(Bt[n][k], At[m][k], acc[ai][bj][m][n], 0, 0, 0); __builtin_amdgcn_s_setprio(0); } while (0)
#define PG8_WAIT_V(n) asm volatile("s_waitcnt vmcnt(" #n ")" ::: "memory")
#define PG8_WAIT_L(n) asm volatile("s_waitcnt lgkmcnt(" #n ")" ::: "memory")
#define PG8_BAR __builtin_amdgcn_s_barrier()
#define PG8_SCHED __builtin_amdgcn_sched_barrier(0)
    Unit cur, nxt; int ui = 0;
    if (!S.next(0, cur)) return;
    f32x4 acc[2][2][4][2];
#pragma unroll
    for (int a = 0; a < 2; ++a)
#pragma unroll
        for (int b = 0; b < 2; ++b)
#pragma unroll
            for (int m = 0; m < 4; ++m)
#pragma unroll
                for (int n = 0; n < 2; ++n) acc[a][b][m][n] = (f32x4){0.f, 0.f, 0.f, 0.f};
    bf16x8 At[4][2], B0[2][2], B1[2][2];
    const char* cA = (const char*)g.A + S.a_off(cur); const char* cB = (const char*)g.Bt + S.b_off(cur);
    PG8_STAGE(PG8_SB(0, 0), cB, voffB); PG8_STAGE(PG8_SB(0, 1), cB + hstepB, voffB); PG8_STAGE(PG8_SA(0, 0), cA, voffA); PG8_STAGE(PG8_SA(0, 1), cA + hstepA, voffA);
    if (wr == 1) PG8_BAR;
    PG8_WAIT_V(2); PG8_BAR;
    PG8_STAGE(PG8_SB(1, 0), cB + kstep, voffB); PG8_STAGE(PG8_SA(1, 0), cA + kstep, voffA); PG8_STAGE(PG8_SB(1, 1), cB + hstepB + kstep, voffB);
    PG8_WAIT_V(6); PG8_BAR;
    for (;;) {
        const bool has_next = S.next(ui + 1, nxt);
        const char* nA = has_next ? (const char*)g.A + S.a_off(nxt) : cA; const char* nB = has_next ? (const char*)g.Bt + S.b_off(nxt) : cB;
        for (int t = 0; t < nt; t += 2) {
            const bool last = (t == nt - 2);
            const char* a1 = cA + (size_t)(t + 1) * kstep;
            const char* a2 = last ? nA : cA + (size_t)(t + 2) * kstep; const char* b2 = last ? nB : cB + (size_t)(t + 2) * kstep;
            const char* a3 = a2 + kstep; const char* b3 = b2 + kstep;
            PG8_LDB(B0, 0, 0); PG8_LDB(B1, 0, 1); PG8_SCHED; PG8_LDA(At, 0, 0); PG8_STAGE(PG8_SA(1, 1), a1 + hstepA, voffA);
            PG8_WAIT_V(8); PG8_WAIT_L(0); PG8_BAR; PG8_MMA(0, 0, At, B0); PG8_MMA(0, 1, At, B1); PG8_BAR; PG8_SCHED;
            PG8_LDA(At, 0, 1); PG8_STAGE(PG8_SB(0, 0), b2, voffB); PG8_STAGE(PG8_SB(0, 1), b2 + hstepB, voffB); PG8_STAGE(PG8_SA(0, 0), a2, voffA);
            PG8_WAIT_V(8); PG8_WAIT_L(0); PG8_BAR; PG8_MMA(1, 0, At, B0); PG8_MMA(1, 1, At, B1); PG8_BAR; PG8_SCHED;
            PG8_LDB(B0, 1, 0); PG8_LDB(B1, 1, 1); PG8_SCHED; PG8_LDA(At, 1, 0); PG8_STAGE(PG8_SA(0, 1), a2 + hstepA, voffA);
            PG8_WAIT_V(8); PG8_WAIT_L(0); PG8_BAR; PG8_MMA(0, 0, At, B0); PG8_MMA(0, 1, At, B1); PG8_BAR; PG8_SCHED;
            PG8_LDA(At, 1, 1); PG8_STAGE(PG8_SB(1, 0), b3, voffB); PG8_STAGE(PG8_SB(1, 1), b3 + hstepB, voffB); PG8_STAGE(PG8_SA(1, 0), a3, voffA);
            PG8_WAIT_V(8); PG8_WAIT_L(0); PG8_BAR; PG8_MMA(1, 0, At, B0); PG8_MMA(1, 1, At, B1); PG8_BAR; PG8_SCHED;
        }
        if (wr == 0) PG8_BAR;
        E(acc, cur, wr, wc, fr, fq);
        if (!has_next) break;
#pragma unroll
        for (int a = 0; a < 2; ++a)
#pragma unroll
            for (int b = 0; b < 2; ++b)
#pragma unroll
                for (int m = 0; m < 4; ++m)
#pragma unroll
                    for (int n = 0; n < 2; ++n) acc[a][b][m][n] = (f32x4){0.f, 0.f, 0.f, 0.f};
        cur = nxt; cA = nA; cB = nB; ++ui;
        if (wr == 1) PG8_BAR;
    }
    PG8_WAIT_V(0);
    PG8_BAR;
#undef PG8_SA
#undef PG8_SB
#undef PG8_STAGE
#undef PG8_LDA
#undef PG8_LDB
#undef PG8_MMA
#undef PG8_WAIT_V
#undef PG8_WAIT_L
#undef PG8_BAR
#undef PG8_SCHED
}

struct EpiInProj {
    static constexpr bool PERM = true;
    bf16_t* O; float* side;
    __device__ __forceinline__ void operator()(const f32x4 (&acc)[2][2][4][2], const Unit& u, int wr, int wc, int fr, int fq) const {
        const int row0 = u.pm * BM + wr * 64 + fr;
#pragma unroll
        for (int bj = 0; bj < 2; ++bj) {
            const int colw = u.pn * BM + bj * HALF + wc * 32, col = colw + 8 * fq;
            const bool sg = (colw >= C_GA) && (colw < C_IF);
            const bool sd = (col >= C_IF) && (col < C_END);
#pragma unroll
            for (int ai = 0; ai < 2; ++ai)
#pragma unroll
                for (int m = 0; m < 4; ++m) {
                    const int row = row0 + ai * HALF + m * 16;
                    f32x4 v0 = acc[ai][bj][m][0], v1 = acc[ai][bj][m][1];
                    if (sd) { *(f32x4*)(side + (size_t)row * 16 + (col - C_IF)) = v0; *(f32x4*)(side + (size_t)row * 16 + (col - C_IF) + 4) = v1; }
                    if (sg) {
#pragma unroll
                        for (int j = 0; j < 4; ++j) { v0[j] = sigmoidf_(v0[j]); v1[j] = sigmoidf_(v1[j]); } }
                    u32x4 w; w.x = cvt_pk_bf16(v0[0], v0[1]); w.y = cvt_pk_bf16(v0[2], v0[3]); w.z = cvt_pk_bf16(v1[0], v1[1]); w.w = cvt_pk_bf16(v1[2], v1[3]);
                    *(u32x4*)(O + (size_t)row * NP + col) = w; }
        }
    }
};
template <int SECOND> struct EpiMerge {
    static constexpr bool PERM = true;
    bf16_t* P;
    __device__ __forceinline__ void operator()(const f32x4 (&acc)[2][2][4][2], const Unit& u, int wr, int wc, int fr, int fq) const {
        const int row0 = u.pm * BM + wr * 64 + fr;
#pragma unroll
        for (int bj = 0; bj < 2; ++bj) {
            const int col = u.pn * BM + bj * HALF + wc * 32 + 8 * fq;
#pragma unroll
            for (int ai = 0; ai < 2; ++ai)
#pragma unroll
                for (int m = 0; m < 4; ++m) {
                    const int row = row0 + ai * HALF + m * 16;
                    bf16_t* pa = P + (size_t)row * NP + C_GA + col;
                    const u32x4 ta = *(const u32x4*)pa;
                    const f32x4 v0 = acc[ai][bj][m][0], v1 = acc[ai][bj][m][1];
                    float r[8];
                    if (SECOND) { const u32x4 gb = *(const u32x4*)(P + (size_t)row * NP + C_GB + col);
                        r[0] = bflo(ta.x) + bflo(gb.x) * v0[0]; r[1] = bfhi(ta.x) + bfhi(gb.x) * v0[1]; r[2] = bflo(ta.y) + bflo(gb.y) * v0[2]; r[3] = bfhi(ta.y) + bfhi(gb.y) * v0[3];
                        r[4] = bflo(ta.z) + bflo(gb.z) * v1[0]; r[5] = bfhi(ta.z) + bfhi(gb.z) * v1[1]; r[6] = bflo(ta.w) + bflo(gb.w) * v1[2]; r[7] = bfhi(ta.w) + bfhi(gb.w) * v1[3];
                    } else {
                        r[0] = bflo(ta.x) * v0[0]; r[1] = bfhi(ta.x) * v0[1]; r[2] = bflo(ta.y) * v0[2]; r[3] = bfhi(ta.y) * v0[3];
                        r[4] = bflo(ta.z) * v1[0]; r[5] = bfhi(ta.z) * v1[1]; r[6] = bflo(ta.w) * v1[2]; r[7] = bfhi(ta.w) * v1[3]; }
                    u32x4 w; w.x = cvt_pk_bf16(r[0], r[1]); w.y = cvt_pk_bf16(r[2], r[3]); w.z = cvt_pk_bf16(r[4], r[5]); w.w = cvt_pk_bf16(r[6], r[7]);
                    *(u32x4*)pa = w; }
        }
    }
};
struct EpiResid {
    static constexpr bool PERM = false;
    float* X;
    __device__ __forceinline__ void operator()(const f32x4 (&acc)[2][2][4][2], const Unit& u, int wr, int wc, int fr, int fq) const {
        const int row0 = u.pm * BM + wr * 64 + fr, col0 = u.pn * BM + wc * 32 + 4 * fq;
#pragma unroll
        for (int ai = 0; ai < 2; ++ai)
#pragma unroll
            for (int m = 0; m < 4; ++m) { float* rowp = X + (size_t)(row0 + ai * HALF + m * 16) * D + col0;
#pragma unroll
                for (int bj = 0; bj < 2; ++bj)
#pragma unroll
                    for (int n = 0; n < 2; ++n) { f32x4* p = (f32x4*)(rowp + bj * HALF + n * 16); const f32x4 x = *p; *p = x * DN_ALPHA + acc[ai][bj][m][n]; } }
    }
};
struct EpiSwiglu {
    static constexpr bool PERM = true;
    bf16_t* H; int ldh;
    __device__ __forceinline__ void operator()(const f32x4 (&acc)[2][2][4][2], const Unit& u, int wr, int wc, int fr, int fq) const {
        const int row0 = u.pm * BM + wr * 64 + fr, col = u.pn * HALF + wc * 32 + 8 * fq;
#pragma unroll
        for (int ai = 0; ai < 2; ++ai)
#pragma unroll
            for (int m = 0; m < 4; ++m) {
                float r[8];
#pragma unroll
                for (int n = 0; n < 2; ++n)
#pragma unroll
                    for (int j = 0; j < 4; ++j) { const float gt = acc[ai][0][m][n][j], up = acc[ai][1][m][n][j]; r[4 * n + j] = gt * sigmoidf_(gt) * up; }
                u32x4 w; w.x = cvt_pk_bf16(r[0], r[1]); w.y = cvt_pk_bf16(r[2], r[3]); w.z = cvt_pk_bf16(r[4], r[5]); w.w = cvt_pk_bf16(r[6], r[7]);
                *(u32x4*)(H + (size_t)(row0 + ai * HALF + m * 16) * ldh + col) = w; }
    }
};
struct EpiMoeDown {
    static constexpr bool PERM = true;
    bf16_t* Y; const float* rg;
    __device__ __forceinline__ void operator()(const f32x4 (&acc)[2][2][4][2], const Unit& u, int wr, int wc, int fr, int fq) const {
        const int row0 = u.pm * BM + wr * 64 + fr;
#pragma unroll
        for (int ai = 0; ai < 2; ++ai)
#pragma unroll
            for (int m = 0; m < 4; ++m) { const int row = row0 + ai * HALF + m * 16; const float gsc = rg[row];
#pragma unroll
                for (int bj = 0; bj < 2; ++bj) { const int col = u.pn * BM + bj * HALF + wc * 32 + 8 * fq;
                    const f32x4 v0 = acc[ai][bj][m][0] * gsc, v1 = acc[ai][bj][m][1] * gsc;
                    u32x4 w; w.x = cvt_pk_bf16(v0[0], v0[1]); w.y = cvt_pk_bf16(v0[2], v0[3]); w.z = cvt_pk_bf16(v1[0], v1[1]); w.w = cvt_pk_bf16(v1[2], v1[3]);
                    *(u32x4*)(Y + (size_t)row * D + col) = w; } }
    }
};
}

struct Args { const float* in[21]; float* out; unsigned char* ws; int ph_lo, ph_hi; };
typedef const Args __attribute__((address_space(4)))* CArgs;
struct Frame {
    LAS unsigned char* lds;
    int tid, lane, wave, vcu, G, gw, NGW;
    CArgs ap; float* out; unsigned char* ws;
};
enum { I_X = 0, I_WIN, I_CONVW, I_GBIAS, I_NORMG, I_KVNG, I_WUK, I_WUV, I_RELB, I_WBA, I_WBB, I_WOUT, I_LNG, I_LNB, I_DWG, I_DWU, I_DWD, I_RW, I_EWG, I_EWU, I_EWD };

template <class F>
__device__ __forceinline__ void transpose_item(const F& val, int K, bf16_t* WT, LAS float* scr, int k0, int n0, int lane) {
#pragma unroll 4
    for (int i = 0; i < 32; ++i) { const int kk = 2 * i + (lane >> 5); scr[kk * 33 + (lane & 31)] = val(k0 + kk, n0 + (lane & 31)); }
    LDS_WAIT(); asm volatile("" ::: "memory");
    const int c = lane & 7;
#pragma unroll
    for (int j = 0; j < 4; ++j) { const int n = (lane >> 3) + 8 * j; const LAS float* s = scr + (8 * c) * 33 + n;
        u32x4 o; o.x = pk2(s[0 * 33], s[1 * 33]); o.y = pk2(s[2 * 33], s[3 * 33]); o.z = pk2(s[4 * 33], s[5 * 33]); o.w = pk2(s[6 * 33], s[7 * 33]);
        *(u32x4*)(WT + (size_t)(n0 + n) * K + k0 + 8 * c) = o; }
    LDS_WAIT(); asm volatile("" ::: "memory");
}
struct ValPlain { const float* W; int ldw; __device__ __forceinline__ float operator()(int k, int n) const { return W[(size_t)k * ldw + n]; } };
struct ValInProj { const float* W; const float* uk;
    __device__ __forceinline__ float operator()(int k, int c) const {
        const float* wr = W + (size_t)k * DIN;
        if (c < C_QL) return wr[c];
        if (c < C_BC) { const int h = (c - C_QL) >> 7, cc = (c - C_QL) & 127; const float* a = wr + 1544 + 64 * h; const float* b = uk + (size_t)h * 64 * 128 + cc; float s = 0.f;
#pragma unroll 8
            for (int d = 0; d < 64; ++d) s += a[d] * b[d * 128]; return s; }
        if (c < C_IQ) return wr[2056 + (c - C_BC)];
        if (c < C_IK) return wr[2184 + (c - C_IQ)];
        if (c < C_GA) return wr[2440 + (c - C_IK)];
        if (c < C_GB) return wr[2480 + (c - C_GA)];
        if (c < C_IF) return wr[3504 + (c - C_GB)];
        if (c < C_IW) return wr[1536 + (c - C_IF)];
        if (c < C_END) return wr[2472 + (c - C_IW)];
        return 0.f; } };
struct ValOB { const float* uv; const float* wb;
    __device__ __forceinline__ float operator()(int k, int n) const { const int h = k >> 7; const float* a = uv + (size_t)k * 64; const float* b = wb + (size_t)(64 * h) * D + n; float s = 0.f;
#pragma unroll 8
        for (int d = 0; d < 64; ++d) s += a[d] * b[(size_t)d * D]; return s; } };
struct ValGU { const float* Wg; const float* Wu; int dff;
    __device__ __forceinline__ float operator()(int k, int n) const { const int pn = n >> 8, rr = n & 255; const int col = 128 * pn + (rr & 127); const long dlt = (rr < 128) ? 0l : (long)(Wu - Wg); return Wg[dlt + (long)k * dff + col]; } };

template <class F>
__device__ __forceinline__ void convert_matrix(Frame& F_, const F& val, int K, int N, bf16_t* WT, int& item_base) {
    LAS float* scr = (LAS float*)(F_.lds + F_.wave * 16384);
    const int nkb = K / 64, nnb = N / 32, nitems = nkb * nnb;
    int first = F_.gw - (item_base % F_.NGW); if (first < 0) first += F_.NGW;
    for (int it = first; it < nitems; it += F_.NGW) { const int kb = it / nnb, nb = it % nnb; transpose_item(val, K, WT, scr, 64 * kb, 32 * nb, F_.lane); }
    item_base += nitems;
}

template <int MODE, bool ROUTE>
__device__ __forceinline__ void ln_pass(Frame& F, int l, int which, int hf, const bf16_t* ys, const unsigned* tdest) {
    const float* g = F.ap->in[I_LNG] + (size_t)(l * 2 + which) * D; const float* b = F.ap->in[I_LNB] + (size_t)(l * 2 + which) * D;
    bf16_t* xb = (bf16_t*)(F.ws + WS_XB);
    LAS float* rw = (LAS float*)F.lds;
    LAS unsigned* lcnt = (LAS unsigned*)(F.lds + 32768);
    if (ROUTE) {
        const float* RW = F.ap->in[I_RW] + (size_t)(l >> 1) * D * NEXP;
        for (int i = F.tid; i < D * NEXP; i += 512) rw[i] = RW[i];
        if (F.tid < 8) lcnt[F.tid] = 0u;
        __syncthreads();
    }
    f32x4 gv[4], bv[4];
#pragma unroll
    for (int j = 0; j < 4; ++j) { gv[j] = *(const f32x4*)(g + 4 * F.lane + 256 * j); bv[j] = *(const f32x4*)(b + 4 * F.lane + 256 * j); }
    for (int r = F.gw; r < MH; r += F.NGW) {
        const size_t grow = (size_t)hf * MH + r;
        float* xr = F.out + grow * D + 4 * F.lane;
        f32x4 v[4]; float s = 0.f;
#pragma unroll
        for (int j = 0; j < 4; ++j) v[j] = *(const f32x4*)(xr + 256 * j);
        if (MODE == 1) {
            const unsigned d0 = tdest[2 * r], d1 = tdest[2 * r + 1];
            const bf16_t* y0 = ys + (size_t)d0 * D + 4 * F.lane; const bf16_t* y1 = ys + (size_t)d1 * D + 4 * F.lane;
#pragma unroll
            for (int j = 0; j < 4; ++j) { const u32x2 a = *(const u32x2*)(y0 + 256 * j), c = *(const u32x2*)(y1 + 256 * j);
                v[j][0] = v[j][0] * DN_ALPHA + (bflo(a.x) + bflo(c.x)); v[j][1] = v[j][1] * DN_ALPHA + (bfhi(a.x) + bfhi(c.x));
                v[j][2] = v[j][2] * DN_ALPHA + (bflo(a.y) + bflo(c.y)); v[j][3] = v[j][3] * DN_ALPHA + (bfhi(a.y) + bfhi(c.y)); }
        }
#pragma unroll
        for (int j = 0; j < 4; ++j) s += (v[j][0] + v[j][1]) + (v[j][2] + v[j][3]);
        const float mean = wave_sum(s) * (1.f / D); float s2 = 0.f;
#pragma unroll
        for (int j = 0; j < 4; ++j) { v[j] = v[j] - mean; s2 += (v[j][0] * v[j][0] + v[j][1] * v[j][1]) + (v[j][2] * v[j][2] + v[j][3] * v[j][3]); }
        const float rstd = 1.f / sqrtf(wave_sum(s2) * (1.f / D) + LN_EPS);
#pragma unroll
        for (int j = 0; j < 4; ++j) { v[j] = v[j] * rstd * gv[j] + bv[j]; *(f32x4*)(xr + 256 * j) = v[j];
            u32x2 w; w.x = cvt_pk_bf16(v[j][0], v[j][1]); w.y = cvt_pk_bf16(v[j][2], v[j][3]); *(u32x2*)(xb + grow * D + 4 * F.lane + 256 * j) = w; }
        if (ROUTE) {
            float lg[8];
#pragma unroll
            for (int e = 0; e < 8; ++e) lg[e] = 0.f;
#pragma unroll
            for (int j = 0; j < 4; ++j)
#pragma unroll
                for (int i = 0; i < 4; ++i) { const LAS float* w = rw + (size_t)(4 * F.lane + 256 * j + i) * 8; const f32x4 w0 = *(const LAS f32x4*)w, w1 = *(const LAS f32x4*)(w + 4); const float xv = v[j][i];
                    lg[0] += xv * w0[0]; lg[1] += xv * w0[1]; lg[2] += xv * w0[2]; lg[3] += xv * w0[3]; lg[4] += xv * w1[0]; lg[5] += xv * w1[1]; lg[6] += xv * w1[2]; lg[7] += xv * w1[3]; }
#pragma unroll
            for (int e = 0; e < 8; ++e) lg[e] = wave_sum(lg[e]);
            int e1 = 0; float l1 = lg[0];
#pragma unroll
            for (int e = 1; e < 8; ++e) if (lg[e] > l1) { l1 = lg[e]; e1 = e; }
            int e2 = -1; float l2 = -3.0e38f;
#pragma unroll
            for (int e = 0; e < 8; ++e) if (e != e1 && lg[e] > l2) { l2 = lg[e]; e2 = e; }
            if (F.lane == 0) {
                const float t = __expf(l2 - l1), p1 = 1.f / (1.f + t), p2 = t / (1.f + t);
                ((unsigned*)(F.ws + WS_MISC + MS_TE))[r] = (unsigned)e1 | ((unsigned)e2 << 8);
                ((float*)(F.ws + WS_MISC + MS_TG))[2 * r] = p1; ((float*)(F.ws + WS_MISC + MS_TG))[2 * r + 1] = p2;
                atomicAdd((unsigned*)(lcnt + e1), 1u); atomicAdd((unsigned*)(lcnt + e2), 1u);
            }
        }
    }
    if (ROUTE) { __syncthreads(); if (F.tid < 8) ((unsigned*)(F.ws + WS_MISC + MS_WGC))[F.vcu * 8 + F.tid] = lcnt[F.tid]; }
}

__device__ __forceinline__ void moe_scatter(Frame& F, int hf) {
    LAS unsigned* sh = (LAS unsigned*)F.lds;
    const unsigned* wgc = (const unsigned*)(F.ws + WS_MISC + MS_WGC);
    if (F.tid < 8) { unsigned tot = 0, mine = 0; for (int g = 0; g < F.G; ++g) { const unsigned c = wgc[g * 8 + F.tid]; if (g == F.vcu) mine = tot; tot += c; } sh[16 + F.tid] = tot; sh[F.tid] = mine; sh[8 + F.tid] = 0u; }
    __syncthreads();
    if (F.tid == 0) { unsigned ps = 0; for (int e = 0; e < 8; ++e) { sh[24 + e] = ps; sh[e] += ps; ps += ((sh[16 + e] + 255u) >> 8) << 8; }
        if (F.vcu == 0) { unsigned* meta = (unsigned*)(F.ws + WS_MISC + MS_META); meta[0] = ps >> 8;
            for (int e = 0; e < 8; ++e) { const unsigned b0 = sh[24 + e] >> 8, nb = (sh[16 + e] + 255u) >> 8; for (unsigned j = 0; j < nb; ++j) meta[16 + b0 + j] = (unsigned)e; } } }
    __syncthreads();
    const unsigned* te = (const unsigned*)(F.ws + WS_MISC + MS_TE); const float* tg = (const float*)(F.ws + WS_MISC + MS_TG);
    unsigned* td = (unsigned*)(F.ws + WS_MISC + MS_TD); float* rg = (float*)(F.ws + WS_MISC + MS_RG);
    const bf16_t* xb = (const bf16_t*)(F.ws + WS_XB); bf16_t* xs = (bf16_t*)(F.ws + WS_XS);
    for (int r = F.gw; r < MH; r += F.NGW) {
        const unsigned ee = te[r]; const int e1 = ee & 255, e2 = (ee >> 8) & 255;
        unsigned d0 = 0, d1 = 0;
        if (F.lane == 0) { d0 = sh[e1] + atomicAdd((unsigned*)(sh + 8 + e1), 1u); d1 = sh[e2] + atomicAdd((unsigned*)(sh + 8 + e2), 1u);
            td[2 * r] = d0; td[2 * r + 1] = d1; rg[d0] = tg[2 * r]; rg[d1] = tg[2 * r + 1]; }
        d0 = __builtin_amdgcn_readfirstlane(d0); d1 = __builtin_amdgcn_readfirstlane(d1);
        const bf16_t* src = xb + ((size_t)hf * MH + r) * D + 16 * F.lane;
        const u32x4 a = *(const u32x4*)src, c = *(const u32x4*)(src + 8);
        *(u32x4*)(xs + (size_t)d0 * D + 16 * F.lane) = a; *(u32x4*)(xs + (size_t)d0 * D + 16 * F.lane + 8) = c;
        *(u32x4*)(xs + (size_t)d1 * D + 16 * F.lane) = a; *(u32x4*)(xs + (size_t)d1 * D + 16 * F.lane + 8) = c;
    }
}

__device__ __forceinline__ f32x4 mma16(const LAS bf16_t* A, int lda, const LAS bf16_t* Bt, int ldb, int ksteps, int lane) {
    f32x4 acc = (f32x4){0.f, 0.f, 0.f, 0.f};
    const LAS bf16_t* ap = A + (lane & 15) * lda + 8 * (lane >> 4);
    const LAS bf16_t* bp = Bt + (lane & 15) * ldb + 8 * (lane >> 4);
    for (int ks = 0; ks < ksteps; ++ks) {
        const bf16x8 a = *(const LAS bf16x8*)(ap + 32 * ks), b = *(const LAS bf16x8*)(bp + 32 * ks);
        acc = __builtin_amdgcn_mfma_f32_16x16x32_bf16(a, b, acc, 0, 0, 0);
    }
    return acc;
}
__device__ __forceinline__ float log_sigmoidf_(float x) { return fminf(x, 0.f) - log1pf(__expf(-fabsf(x))); }
__device__ __forceinline__ float siluf_(float x) { return x * sigmoidf_(x); }

__device__ __forceinline__ void conv8(const bf16_t* proj, const float* cw  , int row, int tseq, int ch0, float (&o)[8]) {
#pragma unroll
    for (int i = 0; i < 8; ++i) o[i] = 0.f;
#pragma unroll
    for (int j = 0; j < 4; ++j) {
        if (tseq - 3 + j >= 0) {
            const u32x4 v = *(const u32x4*)(proj + (size_t)(row - 3 + j) * NP + C_QK + ch0);
            const f32x4 w0 = *(const f32x4*)(cw + j * 512 + ch0), w1 = *(const f32x4*)(cw + j * 512 + ch0 + 4);
            o[0] += bflo(v.x) * w0[0]; o[1] += bfhi(v.x) * w0[1]; o[2] += bflo(v.y) * w0[2]; o[3] += bfhi(v.y) * w0[3];
            o[4] += bflo(v.z) * w1[0]; o[5] += bfhi(v.z) * w1[1]; o[6] += bflo(v.w) * w1[2]; o[7] += bfhi(v.w) * w1[3];
        }
    }
#pragma unroll
    for (int i = 0; i < 8; ++i) o[i] = siluf_(o[i]);
}

__device__ __forceinline__ void mlstm_local(Frame& F, int l) {
    const bf16_t* proj = (const bf16_t*)(F.ws + WS_PROJ); const float* side = (const float*)(F.ws + WS_SIDE);
    float* skv = (float*)(F.ws + WS_SKV); float* sn = (float*)(F.ws + WS_SN); float* ssc = (float*)(F.ws + WS_SSC);
    const float* cw = F.ap->in[I_CONVW] + (size_t)l * 4 * 512; const float* gbias = F.ap->in[I_GBIAS] + l * 8;
    LAS bf16_t* Vt = (LAS bf16_t*)F.lds;
    LAS bf16_t* Kwt = (LAS bf16_t*)(F.lds + 18432);
    LAS float* wsc = (LAS float*)(F.lds + 27648);
    const int lane = F.lane, g4 = lane >> 4;
    for (int u = F.vcu; u < 2048; u += F.G) {
        const int seq = u >> 7, c = u & 127, lb = seq >> 2, hd = seq & 3, r0 = lb * SEQ + 64 * c;
        if (F.wave == 0) {
            const int row = r0 + lane;
            const float ig = side[(size_t)row * 16 + hd] + gbias[hd];
            const float lf = log_sigmoidf_(side[(size_t)row * 16 + 4 + hd] + gbias[4 + hd]);
            float b = lf;
#pragma unroll
            for (int o = 1; o < 64; o <<= 1) { const float t = __shfl_up(b, o); if (lane >= o) b += t; }
            const float blast = __shfl(b, 63);
            const float gl = blast - b + ig;
            float mx = gl;
#pragma unroll
            for (int o = 1; o < 64; o <<= 1) mx = fmaxf(mx, __shfl_xor(mx, o));
            wsc[lane] = __expf(gl - mx);
            if (lane == 0) { ssc[u * 4 + 0] = mx; ssc[u * 4 + 1] = blast; }
        }
        __syncthreads();
        {
            const int s = F.tid >> 3, d8 = (F.tid & 7) * 8; float kv[8];
            conv8(proj, cw, r0 + s, 64 * c + s, 256 + hd * 64 + d8, kv);
            const float sc = 0.125f * wsc[s];
#pragma unroll
            for (int i = 0; i < 8; ++i) Kwt[(d8 + i) * 72 + s] = (bf16_t)f2bf(kv[i] * sc);
            const int v16 = (F.tid & 7) * 16;
            const u32x4 a = *(const u32x4*)(proj + (size_t)(r0 + s) * NP + C_V + hd * 128 + v16), b2 = *(const u32x4*)(proj + (size_t)(r0 + s) * NP + C_V + hd * 128 + v16 + 8);
            const unsigned w[8] = {a.x, a.y, a.z, a.w, b2.x, b2.y, b2.z, b2.w};
#pragma unroll
            for (int i = 0; i < 8; ++i) { Vt[(v16 + 2 * i) * 72 + s] = (bf16_t)(w[i] & 0xffffu); Vt[(v16 + 2 * i + 1) * 72 + s] = (bf16_t)(w[i] >> 16); }
        }
        __syncthreads();
        {
            const int w = F.wave;
#pragma unroll
            for (int dt = 0; dt < 4; ++dt) {
                const f32x4 acc = mma16(Vt + 16 * w * 72, 72, Kwt + 16 * dt * 72, 72, 2, lane);
#pragma unroll
                for (int j = 0; j < 4; ++j) skv[(size_t)u * 8192 + (16 * w + 4 * g4 + j) * 64 + 16 * dt + (lane & 15)] = acc[j];
            }
            if (F.tid < 64) { float s = 0.f; for (int i = 0; i < 64; ++i) s += bf2f(Kwt[F.tid * 72 + i]); sn[u * 64 + F.tid] = s; }
        }
        __syncthreads();
    }
}

__device__ __forceinline__ void mlstm_scan(Frame& F) {
    float* skv = (float*)(F.ws + WS_SKV); float* sn = (float*)(F.ws + WS_SN); float* ssc = (float*)(F.ws + WS_SSC);
    for (int gidx = F.vcu * 512 + F.tid; gidx < 16 * 8192; gidx += F.G * 512) {
        const int seq = gidx >> 13, e = gidx & 8191;
        float C = 0.f, n = 0.f, m = 0.f;
        for (int c0 = 0; c0 < 128; c0 += 8) {
            float kv[8], nv[8], ml[8], bl[8];
#pragma unroll
            for (int i = 0; i < 8; ++i) { const int u = seq * 128 + c0 + i; kv[i] = skv[(size_t)u * 8192 + e]; nv[i] = (e < 64) ? sn[u * 64 + e] : 0.f; ml[i] = ssc[u * 4 + 0]; bl[i] = ssc[u * 4 + 1]; }
#pragma unroll
            for (int i = 0; i < 8; ++i) { const int u = seq * 128 + c0 + i;
                skv[(size_t)u * 8192 + e] = C; if (e < 64) sn[u * 64 + e] = n; if (e == 0) ssc[u * 4 + 2] = m;
                const float mn = fmaxf(bl[i] + m, ml[i]); const float dec = __expf(bl[i] + m - mn), sc = __expf(ml[i] - mn);
                C = dec * C + sc * kv[i]; n = dec * n + sc * nv[i]; m = mn; }
        }
    }
}

__device__ __forceinline__ void mlstm_out(Frame& F, int l) {
    bf16_t* proj = (bf16_t*)(F.ws + WS_PROJ); const float* side = (const float*)(F.ws + WS_SIDE);
    const float* skv = (const float*)(F.ws + WS_SKV); const float* sn = (const float*)(F.ws + WS_SN); const float* ssc = (const float*)(F.ws + WS_SSC);
    const float* cw = F.ap->in[I_CONVW] + (size_t)l * 4 * 512; const float* gbias = F.ap->in[I_GBIAS] + l * 8; const float* ng = F.ap->in[I_NORMG] + (size_t)l * 512;
    LAS bf16_t* Qs = (LAS bf16_t*)F.lds;
    LAS bf16_t* Ks = (LAS bf16_t*)(F.lds + 9216);
    LAS bf16_t* Sw = (LAS bf16_t*)(F.lds + 18432);
    LAS bf16_t* Vt = (LAS bf16_t*)(F.lds + 27648);
    LAS bf16_t* Ct = (LAS bf16_t*)(F.lds + 48384);
    LAS float* Hr = (LAS float*)(F.lds + 69120);
    LAS float* gB = (LAS float*)(F.lds + 107008);
    LAS float* gA = gB + 64;
    LAS float* gM = gB + 128;
    LAS float* gW = gB + 192;
    LAS float* gE = gB + 256;
    const int lane = F.lane, g4 = lane >> 4;
    for (int u = F.vcu; u < 2048; u += F.G) {
        const int seq = u >> 7, c = u & 127, lb = seq >> 2, hd = seq & 3, r0 = lb * SEQ + 64 * c;
        if (F.wave == 0) {
            const int row = r0 + lane;
            const float ig = side[(size_t)row * 16 + hd] + gbias[hd];
            const float lf = log_sigmoidf_(side[(size_t)row * 16 + 4 + hd] + gbias[4 + hd]);
            float b = lf;
#pragma unroll
            for (int o = 1; o < 64; o <<= 1) { const float t = __shfl_up(b, o); if (lane >= o) b += t; }
            const float a = ig - b;
            float pm = a;
#pragma unroll
            for (int o = 1; o < 64; o <<= 1) { const float t = __shfl_up(pm, o); if (lane >= o) pm = fmaxf(pm, t); }
            const float mst = ssc[u * 4 + 2];
            const float mt = fmaxf(b + mst, b + pm);
            gB[lane] = b; gA[lane] = a; gM[lane] = mt; gW[lane] = __expf(b + mst - mt); gE[lane] = __expf(-mt);
        }
        {
            const int s = F.tid >> 3, d8 = (F.tid & 7) * 8; float qv[8], kv[8];
            conv8(proj, cw, r0 + s, 64 * c + s, hd * 64 + d8, qv);
            conv8(proj, cw, r0 + s, 64 * c + s, 256 + hd * 64 + d8, kv);
            u32x4 wq, wk; wq.x = pk2(qv[0], qv[1]); wq.y = pk2(qv[2], qv[3]); wq.z = pk2(qv[4], qv[5]); wq.w = pk2(qv[6], qv[7]);
            wk.x = pk2(kv[0] * 0.125f, kv[1] * 0.125f); wk.y = pk2(kv[2] * 0.125f, kv[3] * 0.125f); wk.z = pk2(kv[4] * 0.125f, kv[5] * 0.125f); wk.w = pk2(kv[6] * 0.125f, kv[7] * 0.125f);
            *(LAS u32x4*)(Qs + s * 72 + d8) = wq; *(LAS u32x4*)(Ks + s * 72 + d8) = wk;
            const int v16 = (F.tid & 7) * 16;
            const u32x4 a = *(const u32x4*)(proj + (size_t)(r0 + s) * NP + C_V + hd * 128 + v16), b2 = *(const u32x4*)(proj + (size_t)(r0 + s) * NP + C_V + hd * 128 + v16 + 8);
            const unsigned w[8] = {a.x, a.y, a.z, a.w, b2.x, b2.y, b2.z, b2.w};
#pragma unroll
            for (int i = 0; i < 8; ++i) { Vt[(v16 + 2 * i) * 72 + s] = (bf16_t)(w[i] & 0xffffu); Vt[(v16 + 2 * i + 1) * 72 + s] = (bf16_t)(w[i] >> 16); }
            for (int i = F.tid; i < 16 * 64; i += 512) { const int rr = 128 + (i >> 6), cc = i & 63; Vt[rr * 72 + cc] = (bf16_t)(rr == 128 ? 0x3F80u : 0u); Ct[rr * 72 + cc] = (bf16_t)(rr == 128 ? f2bf(sn[u * 64 + cc]) : 0u); }
            const int v = F.tid >> 2, d16 = (F.tid & 3) * 16; const float* cp = skv + (size_t)u * 8192 + v * 64 + d16;
            const f32x4 c0 = *(const f32x4*)cp, c1 = *(const f32x4*)(cp + 4), c2 = *(const f32x4*)(cp + 8), c3 = *(const f32x4*)(cp + 12);
            u32x4 o0, o1; o0.x = pk2(c0[0], c0[1]); o0.y = pk2(c0[2], c0[3]); o0.z = pk2(c1[0], c1[1]); o0.w = pk2(c1[2], c1[3]);
            o1.x = pk2(c2[0], c2[1]); o1.y = pk2(c2[2], c2[3]); o1.z = pk2(c3[0], c3[1]); o1.w = pk2(c3[2], c3[3]);
            *(LAS u32x4*)(Ct + v * 72 + d16) = o0; *(LAS u32x4*)(Ct + v * 72 + d16 + 8) = o1;
        }
        __syncthreads();
        {
            const int tt = F.wave >> 1;
#pragma unroll
            for (int i = 0; i < 2; ++i) { const int st = 2 * (F.wave & 1) + i;
                f32x4 acc = (f32x4){0.f, 0.f, 0.f, 0.f};
                if (st <= tt) acc = mma16(Qs + 16 * tt * 72, 72, Ks + 16 * st * 72, 72, 2, lane);
                const int s = 16 * st + (lane & 15); const float as = gA[s];
#pragma unroll
                for (int j = 0; j < 4; ++j) { const int t = 16 * tt + 4 * g4 + j; const float val = (s <= t) ? acc[j] * __expf(gB[t] - gM[t] + as) : 0.f; Sw[t * 72 + s] = (bf16_t)f2bf(val); } }
        }
        __syncthreads();
        {
            const int tt = F.wave & 3, v0 = (F.wave < 4) ? 0 : 5, v1 = (F.wave < 4) ? 5 : 9;
            for (int vt = v0; vt < v1; ++vt) {
                const f32x4 a1 = mma16(Sw + 16 * tt * 72, 72, Vt + 16 * vt * 72, 72, 2, lane);
                const f32x4 a2 = mma16(Qs + 16 * tt * 72, 72, Ct + 16 * vt * 72, 72, 2, lane);
#pragma unroll
                for (int j = 0; j < 4; ++j) { const int t = 16 * tt + 4 * g4 + j; Hr[t * 148 + 16 * vt + (lane & 15)] = a1[j] + gW[t] * a2[j]; } }
        }
        __syncthreads();
        {
            const int t = F.tid >> 3, v16 = (F.tid & 7) * 16;
            const float den = Hr[t * 148 + 128], dd = fmaxf(fabsf(den), gE[t]), inv = 1.f / dd;
            float h[16], s = 0.f;
#pragma unroll
            for (int i = 0; i < 16; ++i) { h[i] = Hr[t * 148 + v16 + i] * inv; s += h[i]; }
            s += __shfl_xor(s, 1); s += __shfl_xor(s, 2); s += __shfl_xor(s, 4);
            const float mu = s * (1.f / 128.f); float q = 0.f;
#pragma unroll
            for (int i = 0; i < 16; ++i) { h[i] -= mu; q += h[i] * h[i]; }
            q += __shfl_xor(q, 1); q += __shfl_xor(q, 2); q += __shfl_xor(q, 4);
            const float rstd = 1.f / sqrtf(q * (1.f / 128.f) + LN_EPS);
            bf16_t* rowp = proj + (size_t)(r0 + t) * NP;
            const u32x4 ao0 = *(const u32x4*)(rowp + C_O + hd * 128 + v16), ao1 = *(const u32x4*)(rowp + C_O + hd * 128 + v16 + 8);
            const unsigned aw[8] = {ao0.x, ao0.y, ao0.z, ao0.w, ao1.x, ao1.y, ao1.z, ao1.w};
            unsigned ow[8];
#pragma unroll
            for (int i = 0; i < 8; ++i) { const float y0 = h[2 * i] * rstd * ng[hd * 128 + v16 + 2 * i] * sigmoidf_(bflo(aw[i])), y1 = h[2 * i + 1] * rstd * ng[hd * 128 + v16 + 2 * i + 1] * sigmoidf_(bfhi(aw[i])); ow[i] = EXP_ZERO_MLSTM ? 0u : pk2(y0, y1); }
            *(u32x4*)(rowp + C_V + hd * 128 + v16) = (u32x4){ow[0], ow[1], ow[2], ow[3]}; *(u32x4*)(rowp + C_V + hd * 128 + v16 + 8) = (u32x4){ow[4], ow[5], ow[6], ow[7]};
        }
        __syncthreads();
    }
}

__device__ __forceinline__ void ckv_pass(Frame& F, int l) {
    const bf16_t* proj = (const bf16_t*)(F.ws + WS_PROJ); bf16_t* ckv = (bf16_t*)(F.ws + WS_CKV); bf16_t* ikp = (bf16_t*)(F.ws + WS_IKP);
    const float* kg = F.ap->in[I_KVNG] + (size_t)l * 128;
    const int l16 = F.lane & 15, rs = F.lane >> 4;
    const f32x4 g0 = *(const f32x4*)(kg + 8 * l16), g1 = *(const f32x4*)(kg + 8 * l16 + 4);
    for (int r4 = F.gw; r4 < MH / 4; r4 += F.NGW) {
        const int row = 4 * r4 + rs;
        const u32x4 v = *(const u32x4*)(proj + (size_t)row * NP + C_BC + 8 * l16);
        float x[8] = {bflo(v.x), bfhi(v.x), bflo(v.y), bfhi(v.y), bflo(v.z), bfhi(v.z), bflo(v.w), bfhi(v.w)};
        float ss = 0.f;
#pragma unroll
        for (int i = 0; i < 8; ++i) ss += x[i] * x[i];
        ss += __shfl_xor(ss, 1); ss += __shfl_xor(ss, 2); ss += __shfl_xor(ss, 4); ss += __shfl_xor(ss, 8);
        const float rr = 1.f / sqrtf(ss * (1.f / 128.f) + LN_EPS);
        u32x4 o; o.x = pk2(x[0] * rr * g0[0], x[1] * rr * g0[1]); o.y = pk2(x[2] * rr * g0[2], x[3] * rr * g0[3]);
        o.z = pk2(x[4] * rr * g1[0], x[5] * rr * g1[1]); o.w = pk2(x[6] * rr * g1[2], x[7] * rr * g1[3]);
        *(u32x4*)(ckv + (size_t)row * 128 + 8 * l16) = o;
        if (l16 < 4) *(u32x4*)(ikp + (size_t)row * 32 + 8 * l16) = *(const u32x4*)(proj + (size_t)row * NP + C_IK + 8 * l16);
    }
}

__device__ __forceinline__ unsigned f2sort(unsigned u) { return u ^ ((u >> 31) ? 0xFFFFFFFFu : 0x80000000u); }
__device__ __forceinline__ float sort2f(unsigned u) { return __builtin_bit_cast(float, (u & 0x80000000u) ? (u ^ 0x80000000u) : ~u); }
__device__ __forceinline__ float topk_compact(LAS u32x2* buf, int n, int lane) {
    unsigned u[8], ky[8], sc[8];
#pragma unroll
    for (int j = 0; j < 8; ++j) { const int e = j * 64 + lane; u32x2 v = (u32x2){0u, 0u}; if (e < n) v = buf[e]; sc[j] = v.x; ky[j] = v.y; u[j] = (e < n) ? f2sort(v.x) : 0u; }
    unsigned thr = 0u;
    for (int bit = 31; bit >= 0; --bit) {
        const unsigned cand = thr | (1u << bit); int c = 0;
#pragma unroll
        for (int j = 0; j < 8; ++j) c += __popcll(__ballot(u[j] >= cand));
        if (c >= 256) thr = cand;
    }
    int cgt = 0;
#pragma unroll
    for (int j = 0; j < 8; ++j) cgt += __popcll(__ballot(u[j] > thr));
    const int need = 256 - cgt; int pos = 0, eqs = 0;
#pragma unroll
    for (int j = 0; j < 8; ++j) {
        const bool gt = u[j] > thr, eq = u[j] == thr;
        const unsigned long long meq = __ballot(eq);
        const bool keep = gt || (eq && (int)(eqs + mbcnt64(meq)) < need);
        const unsigned long long mk = __ballot(keep);
        if (keep) buf[pos + mbcnt64(mk)] = (u32x2){sc[j], ky[j]};
        pos += __popcll(mk); eqs += __popcll(meq);
    }
    return sort2f(thr);
}
__device__ __forceinline__ void topk_phase(Frame& F) {
    const bf16_t* proj = (const bf16_t*)(F.ws + WS_PROJ); const float* side = (const float*)(F.ws + WS_SIDE); const bf16_t* ikp = (const bf16_t*)(F.ws + WS_IKP);
    unsigned short* idxo = (unsigned short*)(F.ws + WS_IDX);
    LAS u32x2* wb = (LAS u32x2*)(F.lds + F.wave * 16384);
    const int lane = F.lane, hh = lane >> 5;
    const float NEG_INF = -__builtin_inff();
    for (int task = F.gw; task < 8192; task += F.NGW) {
        const int lb = task >> 11, sidx = task & 2047;
        const int s2 = (sidx + 1024) & 2047;
        const int tg = (lb == 0) ? sidx : (lb == 1) ? 2047 - sidx : (lb == 2) ? s2 : 2047 - s2;
        const int t0 = 4 * tg, rb = lb * SEQ;
        bf16x8 aq0, aq1;
        { const int q = (lane & 31) >> 3, h = lane & 7; const bf16_t* p = proj + (size_t)(rb + t0 + q) * NP + C_IQ + h * 32 + 8 * hh; aq0 = *(const bf16x8*)p; aq1 = *(const bf16x8*)(p + 16); }
        float wq[16];
#pragma unroll
        for (int r = 0; r < 16; ++r) wq[r] = side[(size_t)(rb + t0 + (r >> 2)) * 16 + 8 + (r & 3) + 4 * hh] * 0.0625f;
        float tau_a = NEG_INF, tau_b = NEG_INF; int c0 = 0, c1 = 0, c2 = 0, c3 = 0;
        const int ntile = (t0 + 3) / 32 + 1;
        for (int j = 0; j < ntile; ++j) {
            if (c0 > 480) { const float t = topk_compact(wb, c0, lane); c0 = 256; if (!hh) tau_a = t; }
            if (c1 > 480) { const float t = topk_compact(wb + 512, c1, lane); c1 = 256; if (!hh) tau_b = t; }
            if (c2 > 480) { const float t = topk_compact(wb + 1024, c2, lane); c2 = 256; if (hh) tau_a = t; }
            if (c3 > 480) { const float t = topk_compact(wb + 1536, c3, lane); c3 = 256; if (hh) tau_b = t; }
            const int key = 32 * j + (lane & 31);
            const bf16_t* kp = ikp + (size_t)(rb + key) * 32 + 8 * hh;
            const bf16x8 b0 = *(const bf16x8*)kp, b1 = *(const bf16x8*)(kp + 16);
            f32x16 acc;
#pragma unroll
            for (int r = 0; r < 16; ++r) acc[r] = 0.f;
            acc = __builtin_amdgcn_mfma_f32_32x32x16_bf16(aq0, b0, acc, 0, 0, 0);
            acc = __builtin_amdgcn_mfma_f32_32x32x16_bf16(aq1, b1, acc, 0, 0, 0);
            float p[4];
#pragma unroll
            for (int q = 0; q < 4; ++q) p[q] = (fmaxf(acc[4 * q], 0.f) * wq[4 * q] + fmaxf(acc[4 * q + 1], 0.f) * wq[4 * q + 1]) + (fmaxf(acc[4 * q + 2], 0.f) * wq[4 * q + 2] + fmaxf(acc[4 * q + 3], 0.f) * wq[4 * q + 3]);
            auto r02 = __builtin_amdgcn_permlane32_swap(__float_as_uint(p[0]), __float_as_uint(p[2]), false, false);
            auto r13 = __builtin_amdgcn_permlane32_swap(__float_as_uint(p[1]), __float_as_uint(p[3]), false, false);
            const unsigned r02a = r02[0], r02b = r02[1], r13a = r13[0], r13b = r13[1];
            const float sa = __uint_as_float(r02a) + __uint_as_float(r02b);
            const float sb = __uint_as_float(r13a) + __uint_as_float(r13b);
            {
                const bool pa = (key <= t0 + 2 * hh) && (sa > tau_a);
                const unsigned long long m = __ballot(pa); const unsigned mlo = (unsigned)m, mhi = (unsigned)(m >> 32);
                const unsigned off = hh ? __builtin_amdgcn_mbcnt_hi(mhi, 0u) : __builtin_amdgcn_mbcnt_lo(mlo, 0u);
                if (pa) wb[(hh ? 1024 + c2 : c0) + off] = (u32x2){__builtin_bit_cast(unsigned, sa), (unsigned)key};
                c0 += __popc(mlo); c2 += __popc(mhi);
            }
            {
                const bool pb = (key <= t0 + 1 + 2 * hh) && (sb > tau_b);
                const unsigned long long m = __ballot(pb); const unsigned mlo = (unsigned)m, mhi = (unsigned)(m >> 32);
                const unsigned off = hh ? __builtin_amdgcn_mbcnt_hi(mhi, 0u) : __builtin_amdgcn_mbcnt_lo(mlo, 0u);
                if (pb) wb[(hh ? 1536 + c3 : 512 + c1) + off] = (u32x2){__builtin_bit_cast(unsigned, sb), (unsigned)key};
                c1 += __popc(mlo); c3 += __popc(mhi);
            }
        }
        if (c0 > 256) { topk_compact(wb, c0, lane); c0 = 256; }
        if (c1 > 256) { topk_compact(wb + 512, c1, lane); c1 = 256; }
        if (c2 > 256) { topk_compact(wb + 1024, c2, lane); c2 = 256; }
        if (c3 > 256) { topk_compact(wb + 1536, c3, lane); c3 = 256; }
#pragma unroll
        for (int q = 0; q < 4; ++q) {
            const int n = (q == 0) ? c0 : (q == 1) ? c1 : (q == 2) ? c2 : c3;
            unsigned k4[4];
#pragma unroll
            for (int i = 0; i < 4; ++i) { const int pz = 4 * lane + i; k4[i] = (pz < n) ? wb[q * 512 + pz].y : 0u; }
            *(u32x2*)(idxo + (size_t)(rb + t0 + q) * 256 + 4 * lane) = (u32x2){k4[0] | (k4[1] << 16), k4[2] | (k4[3] << 16)};
        }
    }
}

__device__ __forceinline__ unsigned offb(unsigned row, unsigned ch) { return 256u * row + 16u * (ch ^ (((row & 3u) << 2) | ((row >> 2) & 3u))); }
__device__ __forceinline__ bf16x8 tr_read2(unsigned a0, unsigned a1) {
    u32x2 r0, r1;
    asm volatile("ds_read_b64_tr_b16 %0, %2\n\tds_read_b64_tr_b16 %1, %3\n\ts_waitcnt lgkmcnt(0)" : "=&v"(r0), "=&v"(r1) : "v"(a0), "v"(a1) : "memory");
    const u32x4 v = (u32x4){r0.x, r0.y, r1.x, r1.y};
    return __builtin_bit_cast(bf16x8, v);
}
__device__ __forceinline__ void attn_phase(Frame& F) {
    bf16_t* proj = (bf16_t*)(F.ws + WS_PROJ); const bf16_t* ckv = (const bf16_t*)(F.ws + WS_CKV); const unsigned short* idxg = (const unsigned short*)(F.ws + WS_IDX);
    const float* relb = F.ap->in[I_RELB];
    LAS float* biasl = (LAS float*)(F.lds + LDS_AUX);
    LAS unsigned short* idxs = (LAS unsigned short*)(F.lds + LDS_AUX + 4608 + F.wave * 512);
    LAS unsigned char* tile = F.lds + F.wave * 16384;
    const unsigned tile_addr = (unsigned)(uintptr_t)tile;
    for (int i = F.tid; i < 129 * 8; i += 512) { const int d = i >> 3, h = i & 7; int bk = d;
        if (d >= 16) { bk = 16 + (int)(logf((float)d * (1.f / 16.f)) / logf(8.f) * 16.f); if (bk > 31) bk = 31; }
        biasl[i] = relb[bk * 8 + h]; }
    __syncthreads();
    const int lane = F.lane, g4 = lane >> 4, c15 = lane & 15, qq = c15 >> 2, pp = lane & 3;
    const bool hv = c15 < 8;
    for (int r = F.gw; r < MH; r += F.NGW) {
        const int t = r & (SEQ - 1), lb = r >> 13;
        const int nsel = (t + 1 < 256) ? t + 1 : 256;
        *(LAS u32x2*)(idxs + 4 * lane) = *(const u32x2*)(idxg + (size_t)r * 256 + 4 * lane);
        bf16x8 bq[4];
#pragma unroll
        for (int ks = 0; ks < 4; ++ks) { u32x4 v = (u32x4){0u, 0u, 0u, 0u}; if (hv) v = *(const u32x4*)(proj + (size_t)r * NP + C_QL + c15 * 128 + 32 * ks + 8 * g4); bq[ks] = __builtin_bit_cast(bf16x8, v); }
        float mrun = -1e30f, lsum = 0.f;
        f32x4 O[8];
#pragma unroll
        for (int c = 0; c < 8; ++c) O[c] = (f32x4){0.f, 0.f, 0.f, 0.f};
        LDS_WAIT();
        const int nch = (nsel + 63) >> 6;
        for (int cch = 0; cch < nch; ++cch) {
            f32x4 L[4];
#pragma unroll
            for (int grp = 0; grp < 4; ++grp) {
                const int key = idxs[64 * cch + 16 * grp + c15];
                const bf16_t* kr = ckv + (size_t)(lb * SEQ + key) * 128 + 8 * g4;
                u32x4 kv[4];
#pragma unroll
                for (int ks = 0; ks < 4; ++ks) kv[ks] = *(const u32x4*)(kr + 32 * ks);
                f32x4 a = (f32x4){0.f, 0.f, 0.f, 0.f};
#pragma unroll
                for (int ks = 0; ks < 4; ++ks) { *(LAS u32x4*)(tile + offb(16 * grp + c15, 4 * ks + g4)) = kv[ks]; a = __builtin_amdgcn_mfma_f32_16x16x32_bf16(__builtin_bit_cast(bf16x8, kv[ks]), bq[ks], a, 0, 0, 0); }
                L[grp] = a;
            }
            float cmax = -1e30f;
#pragma unroll
            for (int grp = 0; grp < 4; ++grp) {
                const u32x2 k4 = *(const LAS u32x2*)(idxs + 64 * cch + 16 * grp + 4 * g4);
                const int kk[4] = {(int)(k4.x & 0xffffu), (int)(k4.x >> 16), (int)(k4.y & 0xffffu), (int)(k4.y >> 16)};
#pragma unroll
                for (int j = 0; j < 4; ++j) { const int pz = 64 * cch + 16 * grp + 4 * g4 + j; int d = t - kk[j]; d = d < 0 ? 0 : (d > 128 ? 128 : d);
                    float lg = L[grp][j] * 0.125f + biasl[d * 8 + (c15 & 7)];
                    lg = (pz < nsel) ? lg : -1e30f; L[grp][j] = lg; cmax = fmaxf(cmax, lg); }
            }
            cmax = fmaxf(cmax, __shfl_xor(cmax, 16)); cmax = fmaxf(cmax, __shfl_xor(cmax, 32));
            const float mnew = fmaxf(mrun, cmax), alpha = __expf(mrun - mnew);
            float ps = 0.f;
#pragma unroll
            for (int grp = 0; grp < 4; ++grp)
#pragma unroll
                for (int j = 0; j < 4; ++j) { float pv = __expf(L[grp][j] - mnew); pv = (hv && L[grp][j] > -1e29f) ? pv : 0.f; L[grp][j] = pv; ps += pv; }
            lsum = lsum * alpha + ps; mrun = mnew;
            bf16x8 pa[2];
#pragma unroll
            for (int kk2 = 0; kk2 < 2; ++kk2) { const u32x4 v = (u32x4){cvt_pk_bf16(L[2 * kk2][0], L[2 * kk2][1]), cvt_pk_bf16(L[2 * kk2][2], L[2 * kk2][3]), cvt_pk_bf16(L[2 * kk2 + 1][0], L[2 * kk2 + 1][1]), cvt_pk_bf16(L[2 * kk2 + 1][2], L[2 * kk2 + 1][3])}; pa[kk2] = __builtin_bit_cast(bf16x8, v); }
            float ar[4];
#pragma unroll
            for (int j = 0; j < 4; ++j) ar[j] = __shfl(alpha, 4 * (g4 & 1) + j);
#pragma unroll
            for (int c = 0; c < 8; ++c)
#pragma unroll
                for (int j = 0; j < 4; ++j) O[c][j] *= ar[j];
            LDS_WAIT();
#pragma unroll
            for (int c = 0; c < 8; ++c)
#pragma unroll
                for (int kk2 = 0; kk2 < 2; ++kk2) {
                    const unsigned a0 = tile_addr + offb(32 * kk2 + 4 * g4 + qq, 2 * c + (pp >> 1)) + 8 * (pp & 1);
                    const unsigned a1 = tile_addr + offb(32 * kk2 + 16 + 4 * g4 + qq, 2 * c + (pp >> 1)) + 8 * (pp & 1);
                    const bf16x8 bv = tr_read2(a0, a1);
                    O[c] = __builtin_amdgcn_mfma_f32_16x16x32_bf16(pa[kk2], bv, O[c], 0, 0, 0);
                }
        }
        lsum += __shfl_xor(lsum, 16); lsum += __shfl_xor(lsum, 32);
        const float inv = 1.f / lsum;
        float ir[4];
#pragma unroll
        for (int j = 0; j < 4; ++j) ir[j] = __shfl(inv, 4 * (g4 & 1) + j);
        if (g4 < 2) {
#pragma unroll
            for (int c = 0; c < 8; ++c)
#pragma unroll
                for (int j = 0; j < 4; ++j) proj[(size_t)r * NP + C_QL + (4 * g4 + j) * 128 + 16 * c + c15] = (bf16_t)f2bf(EXP_ZERO_DSA ? 0.f : O[c][j] * ir[j]);
        }
    }
}
__device__ __forceinline__ void prologue(Frame& F) {
    int base = 0;
    for (int l = 0; l < DEPTH; ++l) {
        unsigned char* wm = F.ws + WS_WMIX + (size_t)l * WMIX_LAYER;
        { ValInProj v{F.ap->in[I_WIN] + (size_t)l * D * DIN, F.ap->in[I_WUK] + (size_t)l * 8 * 64 * 128}; convert_matrix(F, v, D, NP, (bf16_t*)(wm + WM_IN), base); }
        { ValPlain v{F.ap->in[I_WBA] + (size_t)l * 512 * D, D}; convert_matrix(F, v, 512, D, (bf16_t*)(wm + WM_A), base); }
        { ValOB v{F.ap->in[I_WUV] + (size_t)l * 8 * 128 * 64, F.ap->in[I_WBB] + (size_t)l * 512 * D}; convert_matrix(F, v, D, D, (bf16_t*)(wm + WM_OB), base); }
        { ValPlain v{F.ap->in[I_WOUT] + (size_t)l * D * D, D}; convert_matrix(F, v, D, D, (bf16_t*)(wm + WM_OUT), base); }
    }
    bf16_t* xb = (bf16_t*)(F.ws + WS_XB);
    for (int r = F.gw; r < BATCH * SEQ; r += F.NGW) {
        const float* xr = F.ap->in[I_X] + (size_t)r * D + 4 * F.lane;
#pragma unroll
        for (int j = 0; j < 4; ++j) { const f32x4 v = *(const f32x4*)(xr + 256 * j); *(f32x4*)(F.out + (size_t)r * D + 4 * F.lane + 256 * j) = v;
            u32x2 w; w.x = cvt_pk_bf16(v[0], v[1]); w.y = cvt_pk_bf16(v[2], v[3]); *(u32x2*)(xb + (size_t)r * D + 4 * F.lane + 256 * j) = w; }
    }
}
__device__ __forceinline__ void ffn_weights(Frame& F, int l) {
    int base = 0; const int j = l >> 1;
    if ((l & 1) == 0) {
        { ValGU v{F.ap->in[I_DWG] + (size_t)j * D * DFF, F.ap->in[I_DWU] + (size_t)j * D * DFF, DFF}; convert_matrix(F, v, D, 2 * DFF, (bf16_t*)(F.ws + WS_WFFN), base); }
        { ValPlain v{F.ap->in[I_DWD] + (size_t)j * DFF * D, D}; convert_matrix(F, v, DFF, D, (bf16_t*)(F.ws + WS_WFFN + WF_D_OFF), base); }
    } else {
        for (int e = 0; e < NEXP; ++e) {
            { ValGU v{F.ap->in[I_EWG] + (size_t)(j * NEXP + e) * D * DFE, F.ap->in[I_EWU] + (size_t)(j * NEXP + e) * D * DFE, DFE}; convert_matrix(F, v, D, 2 * DFE, (bf16_t*)(F.ws + WS_WFFN + (size_t)e * WF_GU_E), base); }
            { ValPlain v{F.ap->in[I_EWD] + (size_t)(j * NEXP + e) * DFE * D, D}; convert_matrix(F, v, DFE, D, (bf16_t*)(F.ws + WS_WFFN + WF_D_OFF + (size_t)e * WF_D_E), base); }
        }
    }
}

enum { K_PRO = 0, K_FW, K_A, K_B, K_C, K_D, K_E, K_F, K_G, K_H1, K_H2, K_H3, K_H4, K_N };
template <int KIND>
__device__ __forceinline__ void run_phase(Frame& F0, int l, int hf) {
    Frame F = F0;
    { int t = F0.tid; asm volatile("" : "+v"(t)); F.tid = t; F.lane = t & 63; F.wave = __builtin_amdgcn_readfirstlane(t >> 6); }
    int cb = blockIdx.x; asm volatile("" : "+s"(cb)); asm volatile("" : "+s"(l)); asm volatile("" : "+s"(hf));
    { CArgs a = F0.ap; asm volatile("" : "+s"(a)); F.ap = a; F.ws = a->ws; F.out = a->out; }
    F.vcu = cb; F.gw = cb * 8 + F.wave;
    LAS unsigned char* L = F.lds;
    const int G = F.G;
    bf16_t* proj = (bf16_t*)(F.ws + WS_PROJ);
    const unsigned char* wm = F.ws + WS_WMIX + (size_t)l * WMIX_LAYER;
    const bf16_t* xbh = (const bf16_t*)(F.ws + WS_XB) + (size_t)hf * MH * D;
    float* outh = F.out + (size_t)hf * MH * D;
    const bool moe = (l & 1) != 0;
    const unsigned* meta = (const unsigned*)(F.ws + WS_MISC + MS_META);
    if constexpr (KIND == K_PRO) prologue(F);
    if constexpr (KIND == K_FW) ffn_weights(F, l);
    if constexpr (KIND == K_A) { pg8::Gemm g{xbh, (const bf16_t*)(wm + WM_IN), D, D, D}; pg8::Order S; S.init(MH / 256, NP / 256, G, cb, g);
        pg8::EpiInProj E{proj, (float*)(F.ws + WS_SIDE)}; pg8::gemm_phase(L, g, S, E, F.tid); }
    if constexpr (KIND == K_B) { mlstm_local(F, l); ckv_pass(F, l); }
    if constexpr (KIND == K_C) { mlstm_scan(F); topk_phase(F); }
    if constexpr (KIND == K_D) { mlstm_out(F, l); attn_phase(F); }
    if constexpr (KIND == K_E) {
        { pg8::Gemm g{proj + C_V, (const bf16_t*)(wm + WM_A), NP, 512, 512}; pg8::Order S; S.init(MH / 256, D / 256, G, cb, g); pg8::EpiMerge<0> E{proj}; pg8::gemm_phase(L, g, S, E, F.tid); }
        { pg8::Gemm g{proj + C_QL, (const bf16_t*)(wm + WM_OB), NP, D, D}; pg8::Order S; S.init(MH / 256, D / 256, G, cb, g); pg8::EpiMerge<1> E{proj}; pg8::gemm_phase(L, g, S, E, F.tid); }
    }
    if constexpr (KIND == K_F) { pg8::Gemm g{proj + C_GA, (const bf16_t*)(wm + WM_OUT), NP, D, D}; pg8::Order S; S.init(MH / 256, D / 256, G, cb, g); pg8::EpiResid E{outh}; pg8::gemm_phase(L, g, S, E, F.tid); }
    if constexpr (KIND == K_G) { if (moe) ln_pass<0, true>(F, l, 0, hf, nullptr, nullptr); else ln_pass<0, false>(F, l, 0, hf, nullptr, nullptr); }
    if constexpr (KIND == K_H1) { if (moe) moe_scatter(F, hf); }
    if constexpr (KIND == K_H2) {
        const int nblk = moe ? (int)meta[0] : MH / 256;
        pg8::Gemm g{moe ? (const bf16_t*)(F.ws + WS_XS) : xbh, (const bf16_t*)(F.ws + WS_WFFN), D, D, D}; pg8::Order S;
        S.init(nblk, moe ? (2 * DFE) / 256 : (2 * DFF) / 256, G, cb, g, moe ? meta + 16 : nullptr, WF_GU_E);
        pg8::EpiSwiglu E{moe ? (bf16_t*)(F.ws + WS_HM) : (bf16_t*)(F.ws + WS_HD), moe ? DFE : DFF}; pg8::gemm_phase(L, g, S, E, F.tid);
    }
    if constexpr (KIND == K_H3) {
        if (moe) { const int nblk = (int)meta[0]; pg8::Gemm g{(const bf16_t*)(F.ws + WS_HM), (const bf16_t*)(F.ws + WS_WFFN + WF_D_OFF), DFE, DFE, DFE}; pg8::Order S;
            S.init(nblk, D / 256, G, cb, g, meta + 16, WF_D_E); pg8::EpiMoeDown E{(bf16_t*)(F.ws + WS_XS), (const float*)(F.ws + WS_MISC + MS_RG)}; pg8::gemm_phase(L, g, S, E, F.tid); }
        else { pg8::Gemm g{(const bf16_t*)(F.ws + WS_HD), (const bf16_t*)(F.ws + WS_WFFN + WF_D_OFF), DFF, DFF, DFF}; pg8::Order S; S.init(MH / 256, D / 256, G, cb, g);
            pg8::EpiResid E{outh}; pg8::gemm_phase(L, g, S, E, F.tid); }
    }
    if constexpr (KIND == K_H4) { if (moe) ln_pass<1, false>(F, l, 1, hf, (const bf16_t*)(F.ws + WS_XS), (const unsigned*)(F.ws + WS_MISC + MS_TD)); else ln_pass<0, false>(F, l, 1, hf, nullptr, nullptr); }
}
__device__ __forceinline__ void frame_init(Frame& F, const Args& args, unsigned char* lds_raw) {
    F.lds = (LAS unsigned char*)lds_raw;
    F.tid = threadIdx.x; F.lane = F.tid & 63; F.wave = __builtin_amdgcn_readfirstlane(F.tid >> 6);
    F.G = gridDim.x; F.vcu = blockIdx.x; F.gw = blockIdx.x * 8 + F.wave; F.NGW = F.G * 8;
    F.ap = (CArgs)__builtin_amdgcn_kernarg_segment_ptr(); F.out = F.ap->out; F.ws = F.ap->ws;
}
template <int KIND> __global__ void __launch_bounds__(512, 2) k_one(Args args) {
    extern __shared__ __attribute__((aligned(16))) unsigned char lds_raw[];
    Frame F; frame_init(F, args, lds_raw);
    run_phase<KIND>(F, args.ph_lo, args.ph_hi);
}
#if MK_ONE_LAUNCH
template <int L, int HF> __device__ __forceinline__ void half_program(Frame& F, const XcdBarrier& bar) {
    run_phase<K_A>(F, L, HF); xcd_barrier(bar);
    run_phase<K_B>(F, L, HF); xcd_barrier(bar);
    run_phase<K_C>(F, L, HF); xcd_barrier(bar);
    run_phase<K_D>(F, L, HF); xcd_barrier(bar);
    run_phase<K_E>(F, L, HF); xcd_barrier(bar);
    run_phase<K_F>(F, L, HF); xcd_barrier(bar);
    run_phase<K_G>(F, L, HF); xcd_barrier(bar);
    if constexpr ((L & 1) != 0) { run_phase<K_H1>(F, L, HF); xcd_barrier(bar); }
    run_phase<K_H2>(F, L, HF); xcd_barrier(bar);
    run_phase<K_H3>(F, L, HF); xcd_barrier(bar);
    run_phase<K_H4>(F, L, HF); if constexpr (!(L == DEPTH - 1 && HF == NHALF - 1)) xcd_barrier(bar);
}
template <int L> __device__ __forceinline__ void layer_program(Frame& F, const XcdBarrier& bar) {
    run_phase<K_FW>(F, L, 0); xcd_barrier(bar);
    half_program<L, 0>(F, bar);
    half_program<L, 1>(F, bar);
}
__global__ void __launch_bounds__(512, 2) fwd(Args args) {
    extern __shared__ __attribute__((aligned(16))) unsigned char lds_raw[];
    Frame F; frame_init(F, args, lds_raw);
    volatile LAS unsigned* ctlw = (volatile LAS unsigned*)(F.lds + LDS_CTLW);
    if (F.tid < 64) ctlw[F.tid] = 0u;
    __syncthreads();
    XcdBarrier bar = xcd_barrier_post((unsigned*)(F.ws + WS_CTL) + CW_BAR, ctlw + 8);
    run_phase<K_PRO>(F, 0, 0); xcd_barrier(bar);
    layer_program<0>(F, bar); layer_program<1>(F, bar); layer_program<2>(F, bar); layer_program<3>(F, bar);
}
#endif

template <int KIND> static void launch_one(int grid, hipStream_t stream, Args a, int l, int hf) {
    static bool attr = false;
    if (!attr) { (void)hipFuncSetAttribute((const void*)k_one<KIND>, hipFuncAttributeMaxDynamicSharedMemorySize, LDS_BYTES); attr = true; }
    a.ph_lo = l; a.ph_hi = hf;
    hipLaunchKernelGGL(k_one<KIND>, dim3(grid), dim3(512), LDS_BYTES, stream, a);
}
extern "C" void kernel_launch(void* const* d_in, const int* in_sizes, int n_in, void* d_out, int out_size, void* d_ws, size_t ws_size, hipStream_t stream) {
    static int grid = 0;
    if (grid == 0) {
        if (n_in != 21 || out_size != BATCH * SEQ * D || ws_size < WS_END) { fprintf(stderr, "kernel_launch: unexpected problem shape (n_in %d, out %d, ws %zu)\n", n_in, out_size, ws_size); grid = -1; return; }
        int dev = 0, cus = 0;
        if (hipGetDevice(&dev) != hipSuccess || hipDeviceGetAttribute(&cus, hipDeviceAttributeMultiprocessorCount, dev) != hipSuccess) { grid = -1; return; }
#if MK_ONE_LAUNCH
        int per_cu = 0;
        if (hipFuncSetAttribute((const void*)fwd, hipFuncAttributeMaxDynamicSharedMemorySize, LDS_BYTES) != hipSuccess) { fprintf(stderr, "kernel_launch: hipFuncSetAttribute failed\n"); grid = -1; return; }
        if (hipOccupancyMaxActiveBlocksPerMultiprocessor(&per_cu, (const void*)fwd, 512, LDS_BYTES) != hipSuccess || per_cu < 1) fprintf(stderr, "kernel_launch: occupancy query reports %d\n", per_cu);
        (void)hipGetLastError();
#endif
        grid = cus;
    }
    if (grid < 0) return;
    (void)in_sizes;
    Args a{};
    for (int i = 0; i < 21; ++i) a.in[i] = (const float*)d_in[i];
    a.out = (float*)d_out; a.ws = (unsigned char*)d_ws;
#if MK_ONE_LAUNCH
    if (hipMemsetAsync((char*)d_ws + WS_CTL, 0, CTL_BYTES, stream) != hipSuccess) return;
    hipLaunchKernelGGL(fwd, dim3(grid), dim3(512), LDS_BYTES, stream, a);
#else
    launch_one<K_PRO>(grid, stream, a, 0, 0);
    for (int l = 0; l < DEPTH; ++l) {
        launch_one<K_FW>(grid, stream, a, l, 0);
        for (int hf = 0; hf < NHALF; ++hf) {
            launch_one<K_A>(grid, stream, a, l, hf); launch_one<K_B>(grid, stream, a, l, hf); launch_one<K_C>(grid, stream, a, l, hf); launch_one<K_D>(grid, stream, a, l, hf);
            launch_one<K_E>(grid, stream, a, l, hf); launch_one<K_F>(grid, stream, a, l, hf); launch_one<K_G>(grid, stream, a, l, hf);
            if (l & 1) launch_one<K_H1>(grid, stream, a, l, hf);
            launch_one<K_H2>(grid, stream, a, l, hf); launch_one<K_H3>(grid, stream, a, l, hf); launch_one<K_H4>(grid, stream, a, l, hf);
        }
    }
#endif
}
```

```cpp
#include <hip/hip_runtime.h>
#include <cstdio>
#include <cstdint>

#ifndef MK_ONE_LAUNCH
#define MK_ONE_LAUNCH 1
#endif

#ifndef WGM_A
#define WGM_A 4
#endif
#ifndef WGM_F
#define WGM_F 4
#endif
#ifndef EXP_ZERO_DSA
#define EXP_ZERO_DSA 0
#endif
#ifndef EXP_ZERO_MLSTM
#define EXP_ZERO_MLSTM 0
#endif
#define LAS __attribute__((address_space(3)))
typedef unsigned short bf16_t;
typedef short bf16x8 __attribute__((ext_vector_type(8)));
typedef float f32x4 __attribute__((ext_vector_type(4)));
typedef float f32x16 __attribute__((ext_vector_type(16)));
typedef unsigned u32x4 __attribute__((ext_vector_type(4)));
typedef unsigned u32x2 __attribute__((ext_vector_type(2)));

constexpr int D = 1024, BATCH = 8, SEQ = 8192, DEPTH = 4;
constexpr int MH = 4 * SEQ;
constexpr int NHALF = 2;
constexpr int NP = 5120;
constexpr int C_QK = 0, C_V = 512, C_O = 1024, C_QL = 1536, C_BC = 2560, C_IQ = 2688, C_IK = 2944, C_GA = 2976, C_GB = 4000, C_IF = 5024, C_IW = 5032, C_END = 5040;
constexpr int DIN = 4528;
constexpr int DFF = 2816, DFE = 3584, NEXP = 8;
constexpr float DN_ALPHA = 1.681792830507429f;
constexpr float LN_EPS = 1e-5f;
constexpr int MOE_ROWS = 2 * MH + NEXP * 256;
constexpr int MOE_BLKS = MOE_ROWS / 256;

constexpr size_t MiB = 1u << 20;
constexpr size_t WS_CTL = 0, CTL_BYTES = 1 * MiB;
constexpr size_t WS_MISC = 1 * MiB;
constexpr size_t WS_WMIX = 5 * MiB;
constexpr size_t WMIX_LAYER = 15 * MiB, WM_IN = 0, WM_A = 10 * MiB, WM_OB = 11 * MiB, WM_OUT = 13 * MiB;
constexpr size_t WS_WFFN = 65 * MiB;
constexpr size_t WF_GU_E = (size_t)2 * DFE * D * 2, WF_D_OFF = (size_t)NEXP * WF_GU_E, WF_D_E = (size_t)D * DFE * 2;
constexpr size_t WS_XB = 233 * MiB;
constexpr size_t WS_R0 = 361 * MiB;
constexpr size_t WS_PROJ = WS_R0;
constexpr size_t WS_CKV = 681 * MiB;
constexpr size_t WS_SIDE = 689 * MiB;
constexpr size_t WS_SKV = 691 * MiB;
constexpr size_t WS_SN = 755 * MiB;
constexpr size_t WS_SSC = 756 * MiB;
constexpr size_t WS_IDX = 757 * MiB;
constexpr size_t WS_IKP = 773 * MiB;
constexpr size_t WS_PRE = WS_SKV;
constexpr size_t WS_YA = 776 * MiB;
constexpr size_t WS_OL = 808 * MiB;
constexpr size_t WS_MG = 872 * MiB;
constexpr size_t WS_GB = 936 * MiB;
constexpr size_t WS_PRE2 = 776 * MiB;
constexpr size_t WS_HD = WS_R0;
constexpr size_t WS_XS = WS_R0;
constexpr size_t WS_HM = 493 * MiB;
constexpr size_t WS_END = 1000 * MiB;
constexpr size_t MS_TE = 0;
constexpr size_t MS_TG = 256 * 1024;
constexpr size_t MS_TD = 512 * 1024;
constexpr size_t MS_RG = 768 * 1024;
constexpr size_t MS_WGC = 1100 * 1024;
constexpr size_t MS_META = 1200 * 1024;
constexpr int CW_BAR = 4096;

constexpr int LDS_MAIN = 131072;
constexpr int LDS_AUX = LDS_MAIN;
constexpr int LDS_CTLW = LDS_MAIN + 14336;
constexpr int LDS_BYTES = 147456;

__device__ __forceinline__ unsigned cvt_pk_bf16(float lo, float hi) { unsigned r; asm volatile("v_cvt_pk_bf16_f32 %0, %1, %2" : "=v"(r) : "v"(lo), "v"(hi)); return r; }
__device__ __forceinline__ unsigned pk2(float lo, float hi) { return cvt_pk_bf16(lo, hi); }
__device__ __forceinline__ unsigned f2bf(float f) { return cvt_pk_bf16(f, 0.f) & 0xffffu; }
__device__ __forceinline__ float bf2f(unsigned short b) { return __builtin_bit_cast(float, ((unsigned)b) << 16); }
__device__ __forceinline__ float bflo(unsigned w) { return __builtin_bit_cast(float, w << 16); }
__device__ __forceinline__ float bfhi(unsigned w) { return __builtin_bit_cast(float, w & 0xffff0000u); }
__device__ __forceinline__ float sigmoidf_(float x) { return __builtin_amdgcn_rcpf(1.f + __builtin_amdgcn_exp2f(x * -1.4426950408889634f)); }
template <int CTRL> __device__ __forceinline__ float dpp_mov(float x) { return __int_as_float(__builtin_amdgcn_mov_dpp(__float_as_int(x), CTRL, 0xf, 0xf, true)); }
__device__ __forceinline__ float row16_sum(float x) { x += dpp_mov<0x128>(x); x += dpp_mov<0x124>(x); x += dpp_mov<0x4E>(x); x += dpp_mov<0xB1>(x); return x; }
__device__ __forceinline__ float wave_sum(float v) {
    { auto s = __builtin_amdgcn_permlane32_swap(__float_as_uint(v), __float_as_uint(v), false, false); const unsigned s0 = s[0], s1 = s[1]; v = __uint_as_float(s0) + __uint_as_float(s1); }
    { auto s = __builtin_amdgcn_permlane16_swap(__float_as_uint(v), __float_as_uint(v), false, false); const unsigned s0 = s[0], s1 = s[1]; v = __uint_as_float(s0) + __uint_as_float(s1); }
    return row16_sum(v);
}
__device__ __forceinline__ unsigned mbcnt64(unsigned long long m) { return __builtin_amdgcn_mbcnt_hi((unsigned)(m >> 32), __builtin_amdgcn_mbcnt_lo((unsigned)m, 0u)); }
#define LDS_WAIT() asm volatile("s_waitcnt lgkmcnt(0)" ::: "memory")
#define VM_WAIT() asm volatile("s_waitcnt vmcnt(0)" ::: "memory")

#define XB_TMO      128
#define XB_XCNT(j)  (256  + 64 * (j))
#define XB_XSUB(j)  (1280 + 64 * (j))
#define XB_XGEN(j)  (2304 + 64 * (j))
#define XB_TOP      3328
#define XB_TOPGEN   3392
#define XCD_BAR_WORDS 3456
#define XB_SPIN_CAP (1u << 18)
__device__ __forceinline__ unsigned xb_ld(unsigned* p)              { return __hip_atomic_load(p, __ATOMIC_RELAXED, __HIP_MEMORY_SCOPE_AGENT); }
__device__ __forceinline__ unsigned xb_add(unsigned* p, unsigned v) { return __hip_atomic_fetch_add(p, v, __ATOMIC_RELAXED, __HIP_MEMORY_SCOPE_AGENT); }
__device__ __forceinline__ unsigned xb_xcc_id() { return (unsigned)__builtin_amdgcn_s_getreg((3 << 11) | 20) & 0xFu; }
#define XB_SPIN(cond, bar) do { unsigned _sp = 0; while (cond) { __builtin_amdgcn_s_sleep(1); \
    if ((++_sp & 255u) == 0u) { if (xb_ld(&(bar)[XB_TMO])) break; if (_sp > XB_SPIN_CAP) { atomicAdd(&(bar)[XB_TMO], 1u); break; } } } } while (0)
struct XcdBarrier { unsigned* bar; unsigned x; volatile LAS unsigned* st; };
__device__ __forceinline__ XcdBarrier xcd_barrier_post(unsigned* bar, volatile LAS unsigned* st) {
    XcdBarrier b; b.bar = bar; b.x = xb_xcc_id(); b.st = st;
    if (threadIdx.x == 0) (void)xb_add(&bar[XB_XCNT(b.x)], 1u);
    return b;
}
__device__ __forceinline__ void xcd_barrier_complete(unsigned* bar, unsigned x, unsigned& nloc, unsigned& nx) {
    const unsigned G = gridDim.x * gridDim.y * gridDim.z;
    unsigned sum, cnt, mine, sp = 0u;
    for (;;) {
        sum = 0u; cnt = 0u; mine = 0u;
#pragma unroll
        for (unsigned j = 0; j < 16; ++j) { const unsigned c = xb_ld(&bar[XB_XCNT(j)]); sum += c; cnt += (c > 0u) ? 1u : 0u; mine = (j == x) ? c : mine; }
        if (sum == G) break;
        __builtin_amdgcn_s_sleep(1);
        if ((++sp & 255u) == 0u) { if (xb_ld(&bar[XB_TMO])) break; if (sp > XB_SPIN_CAP) { atomicAdd(&bar[XB_TMO], 1u); break; } }
    }
    nloc = mine > 0u ? mine : 1u; nx = cnt > 0u ? cnt : 1u;
}
__device__ __attribute__((noinline)) void xcd_barrier(const XcdBarrier b) {
    asm volatile("s_waitcnt vmcnt(0)" ::: "memory");
    __syncthreads();
    if (threadIdx.x == 0) {
        unsigned* bar = b.bar;
        __builtin_amdgcn_s_waitcnt(0);
        unsigned nloc = b.st[0], nx = b.st[1];
        if (nloc == 0u) { xcd_barrier_complete(bar, b.x, nloc, nx); b.st[0] = nloc; b.st[1] = nx; }
        const unsigned old = xb_add(&bar[XB_XSUB(b.x)], 1u);
        const unsigned gen = old / nloc;
        if (old + 1u == (gen + 1u) * nloc) {
            __builtin_amdgcn_fence(__ATOMIC_RELEASE, "agent");
            asm volatile("s_waitcnt vmcnt(0)" ::: "memory");
            const unsigned og = xb_add(&bar[XB_TOP], 1u);
            const unsigned tg = og / nx;
            if (og + 1u == (tg + 1u) * nx) xb_add(&bar[XB_TOPGEN], 1u);
            else XB_SPIN(xb_ld(&bar[XB_TOPGEN]) == tg, bar);
            __builtin_amdgcn_fence(__ATOMIC_ACQUIRE, "agent");
            xb_add(&bar[XB_XGEN(b.x)], 1u);
            asm volatile("s_waitcnt vmcnt(0)" ::: "memory");
        } else {
            XB_SPIN(xb_ld(&bar[XB_XGEN(b.x)]) == gen, bar);
            __builtin_amdgcn_fence(__ATOMIC_ACQUIRE, "agent");
            asm volatile("s_waitcnt vmcnt(0)" ::: "memory");
        }
    }
    __syncthreads();
}

namespace pg8 {
constexpr int BM = 256, BK = 64, HALF = 128, HTB = HALF * BK * 2, STAGE_BYTES = 8 * HTB, NXCD = 8, WGM = 4;
__host__ __device__ __forceinline__ int lds_byte(int r, int c) { const int st = (r >> 4) * 2 + (c >> 5), rr = r & 15, cc = c & 31, ob = rr * 64 + cc * 2; return st * 1024 + (ob ^ (((ob >> 9) & 1) << 5)); }
__host__ __device__ __forceinline__ void stage_rc(int b, int& R, int& C) { const int st = b / 1024, sb = b % 1024, swz = sb ^ (((sb >> 9) & 1) << 5); R = (st >> 1) * 16 + swz / 64; C = (st & 1) * 32 + (swz % 64) / 2; }
__host__ __device__ __forceinline__ int perm32(int rho) { const int n = rho >> 4, i = rho & 15; return 8 * (i >> 2) + 4 * n + (i & 3); }
struct Unit { int pm, pn; };
struct Gemm { const bf16_t* A; const bf16_t* Bt; int lda, ldb, K; };
struct Order {
    int nM, nN, nwg, G, c, wgm; const unsigned* blk_e; size_t b_estride; size_t a_tstep, b_tstep;
    __device__ void init(int nM_, int nN_, int G_, int c_, const Gemm& g, const unsigned* be = nullptr, size_t bes = 0, int wgm_ = WGM) {
        nM = nM_; nN = nN_; nwg = nM * nN; G = G_; c = c_; wgm = wgm_; blk_e = be; b_estride = bes; a_tstep = (size_t)BM * g.lda * 2; b_tstep = (size_t)BM * g.ldb * 2; }
    __device__ bool next(int i, Unit& u) const {
        const long L = (long)i * G + c; if (L >= nwg) return false;
        int wgid = (int)L; { const int q = nwg / NXCD, r = nwg % NXCD, xcd = wgid % NXCD, off = wgid / NXCD; wgid = (xcd < r ? xcd * (q + 1) : r * (q + 1) + (xcd - r) * q) + off; }
        const int nig = wgm * nN, gid = wgid / nig, fm = gid * wgm, gsz = (nM - fm) < wgm ? (nM - fm) : wgm;
        u.pm = fm + ((wgid % nig) % gsz); u.pn = (wgid % nig) / gsz; return true;
    }
    __device__ __forceinline__ size_t a_off(const Unit& u) const { return (size_t)u.pm * a_tstep; }
    __device__ __forceinline__ size_t b_off(const Unit& u) const { size_t o = (size_t)u.pn * b_tstep; if (blk_e) o += (size_t)__builtin_amdgcn_readfirstlane(blk_e[u.pm]) * b_estride; return o; }
};

template <class Epi>
__device__ __forceinline__ void gemm_phase(LAS unsigned char* lds, const Gemm g, const Order& S, const Epi& E, const int tid) {
    const int wid = __builtin_amdgcn_readfirstlane(tid >> 6), lane = tid & 63, wr = wid >> 2, wc = wid & 3, fr = lane & 15, fq = lane >> 4;
    const int K = g.K, nt = K / BK;
    unsigned voffA[2], voffB[2];
#pragma unroll
    for (int i = 0; i < 2; ++i) { int R, C; stage_rc(tid * 16 + i * 8192, R, C); const int Rb = Epi::PERM ? ((R & ~31) + perm32(R & 31)) : R;
        voffA[i] = (unsigned)(R * g.lda + C) * 2u; voffB[i] = (unsigned)(Rb * g.ldb + C) * 2u; }
    const size_t kstep = (size_t)(BK * 2);
    const size_t hstepA = (size_t)HALF * g.lda * 2, hstepB = (size_t)HALF * g.ldb * 2;
    const unsigned ldsw = (unsigned)wid * 1024u;
    const int aoff = lds_byte(wr * 64 + fr, fq * 8), boff = lds_byte(wc * 32 + fr, fq * 8);
#define PG8_SA(b, h) (((b) * 2 + (h)) * HTB)
#define PG8_SB(b, h) ((4 + (b) * 2 + (h)) * HTB)
#define PG8_STAGE(bufoff, gbase, voff) do { _Pragma("unroll") for (int _i = 0; _i < 2; ++_i) \
        __builtin_amdgcn_global_load_lds((const unsigned*)((const char*)(gbase) + (voff)[_i]), (LAS unsigned*)(lds + (bufoff) + ldsw + _i * 8192), 16, 0, 0); } while (0)
#define PG8_LDA(dst, b, h) do { _Pragma("unroll") for (int m = 0; m < 4; ++m) _Pragma("unroll") for (int k = 0; k < 2; ++k) dst[m][k] = *(const LAS bf16x8*)(lds + PG8_SA(b, h) + aoff + m * 2048 + k * 1024); } while (0)
#define PG8_LDB(dst, b, h) do { _Pragma("unroll") for (int n = 0; n < 2; ++n) _Pragma("unroll") for (int k = 0; k < 2; ++k) dst[n][k] = *(const LAS bf16x8*)(lds + PG8_SB(b, h) + boff + n * 2048 + k * 1024); } while (0)
#define PG8_MMA(ai, bj, At, Bt) do { __builtin_amdgcn_s_setprio(1); _Pragma("unroll") for (int m = 0; m < 4; ++m) _Pragma("unroll") for (int n = 0; n < 2; ++n) _Pragma("unroll") for (int k = 0; k < 2; ++k) \
        acc[ai][bj][m][n] = __builtin_amdgcn_mfma_f32_16x16x32_bf16(Bt[n][k], At[m][k], acc[ai][bj][m][n], 0, 0, 0); __builtin_amdgcn_s_setprio(0); } while (0)
#define PG8_WAIT_V(n) asm volatile("s_waitcnt vmcnt(" #n ")" ::: "memory")
#define PG8_WAIT_L(n) asm volatile("s_waitcnt lgkmcnt(" #n ")" ::: "memory")
#define PG8_BAR __builtin_amdgcn_s_barrier()
#define PG8_SCHED __builtin_amdgcn_sched_barrier(0)
    Unit cur, nxt; int ui = 0;
    if (!S.next(0, cur)) return;
    f32x4 acc[2][2][4][2];
#pragma unroll
    for (int a = 0; a < 2; ++a)
#pragma unroll
        for (int b = 0; b < 2; ++b)
#pragma unroll
            for (int m = 0; m < 4; ++m)
#pragma unroll
                for (int n = 0; n < 2; ++n) acc[a][b][m][n] = (f32x4){0.f, 0.f, 0.f, 0.f};
    bf16x8 At[4][2], B0[2][2], B1[2][2];
    const char* cA = (const char*)g.A + S.a_off(cur); const char* cB = (const char*)g.Bt + S.b_off(cur);
    PG8_STAGE(PG8_SB(0, 0), cB, voffB); PG8_STAGE(PG8_SB(0, 1), cB + hstepB, voffB); PG8_STAGE(PG8_SA(0, 0), cA, voffA); PG8_STAGE(PG8_SA(0, 1), cA + hstepA, voffA);
    if (wr == 1) PG8_BAR;
    PG8_WAIT_V(2); PG8_BAR;
    PG8_STAGE(PG8_SB(1, 0), cB + kstep, voffB); PG8_STAGE(PG8_SA(1, 0), cA + kstep, voffA); PG8_STAGE(PG8_SB(1, 1), cB + hstepB + kstep, voffB);
    PG8_WAIT_V(6); PG8_BAR;
    for (;;) {
        const bool has_next = S.next(ui + 1, nxt);
        const char* nA = has_next ? (const char*)g.A + S.a_off(nxt) : cA; const char* nB = has_next ? (const char*)g.Bt + S.b_off(nxt) : cB;
        for (int t = 0; t < nt; t += 2) {
            const bool last = (t == nt - 2);
            const char* a1 = cA + (size_t)(t + 1) * kstep;
            const char* a2 = last ? nA : cA + (size_t)(t + 2) * kstep; const char* b2 = last ? nB : cB + (size_t)(t + 2) * kstep;
            const char* a3 = a2 + kstep; const char* b3 = b2 + kstep;
            PG8_LDB(B0, 0, 0); PG8_LDB(B1, 0, 1); PG8_SCHED; PG8_LDA(At, 0, 0); PG8_STAGE(PG8_SA(1, 1), a1 + hstepA, voffA);
            PG8_WAIT_V(8); PG8_WAIT_L(0); PG8_BAR; PG8_MMA(0, 0, At, B0); PG8_MMA(0, 1, At, B1); PG8_BAR; PG8_SCHED;
            PG8_LDA(At, 0, 1); PG8_STAGE(PG8_SB(0, 0), b2, voffB); PG8_STAGE(PG8_SB(0, 1), b2 + hstepB, voffB); PG8_STAGE(PG8_SA(0, 0), a2, voffA);
            PG8_WAIT_V(8); PG8_WAIT_L(0); PG8_BAR; PG8_MMA(1, 0, At, B0); PG8_MMA(1, 1, At, B1); PG8_BAR; PG8_SCHED;
            PG8_LDB(B0, 1, 0); PG8_LDB(B1, 1, 1); PG8_SCHED; PG8_LDA(At, 1, 0); PG8_STAGE(PG8_SA(0, 1), a2 + hstepA, voffA);
            PG8_WAIT_V(8); PG8_WAIT_L(0); PG8_BAR; PG8_MMA(0, 0, At, B0); PG8_MMA(0, 1, At, B1); PG8_BAR; PG8_SCHED;
            PG8_LDA(At, 1, 1); PG8_STAGE(PG8_SB(1, 0), b3, voffB); PG8_STAGE(PG8_SB(1, 1), b3 + hstepB, voffB); PG8_STAGE(PG8_SA(1, 0), a3, voffA);
            PG8_WAIT_V(8); PG8_WAIT_L(0); PG8_BAR; PG8_MMA(1, 0, At, B0); PG8_MMA(1, 1, At, B1); PG8_BAR; PG8_SCHED;
        }
        if (wr == 0) PG8_BAR;
        E(acc, cur, wr, wc, fr, fq);
        if (!has_next) break;
#pragma unroll
        for (int a = 0; a < 2; ++a)
#pragma unroll
            for (int b = 0; b < 2; ++b)
#pragma unroll
                for (int m = 0; m < 4; ++m)
#pragma unroll
                    for (int n = 0; n < 2; ++n) acc[a][b][m][n] = (f32x4){0.f, 0.f, 0.f, 0.f};
        cur = nxt; cA = nA; cB = nB; ++ui;
        if (wr == 1) PG8_BAR;
    }
    PG8_WAIT_V(0);
    PG8_BAR;
#undef PG8_SA
#undef PG8_SB
#undef PG8_STAGE
#undef PG8_LDA
#undef PG8_LDB
#undef PG8_MMA
#undef PG8_WAIT_V
#undef PG8_WAIT_L
#undef PG8_BAR
#undef PG8_SCHED
}

struct EpiInProj {
    static constexpr bool PERM = true;
    bf16_t* O; float* side; bf16_t* GA; bf16_t* GB;
    __device__ __forceinline__ void operator()(const f32x4 (&acc)[2][2][4][2], const Unit& u, int wr, int wc, int fr, int fq) const {
        const int row0 = u.pm * BM + wr * 64 + fr;
#pragma unroll
        for (int bj = 0; bj < 2; ++bj) {
            const int colw = __builtin_amdgcn_readfirstlane(u.pn * BM + bj * HALF + wc * 32), col = colw + 8 * fq;
            const bool sg = (colw >= C_GA) && (colw < C_IF);
            bf16_t* base = O + col; unsigned ld = NP;
            if (sg) { base = (colw < C_GB) ? GA + (col - C_GA) : GB + (col - C_GB); ld = D; }
            if (sg) {
#pragma unroll
                for (int ai = 0; ai < 2; ++ai)
#pragma unroll
                    for (int m = 0; m < 4; ++m) {
                        const unsigned row = (unsigned)(row0 + ai * HALF + m * 16);
                        f32x4 v0 = acc[ai][bj][m][0], v1 = acc[ai][bj][m][1];
#pragma unroll
                        for (int j = 0; j < 4; ++j) { v0[j] = sigmoidf_(v0[j]); v1[j] = sigmoidf_(v1[j]); }
                        u32x4 w; w.x = cvt_pk_bf16(v0[0], v0[1]); w.y = cvt_pk_bf16(v0[2], v0[3]); w.z = cvt_pk_bf16(v1[0], v1[1]); w.w = cvt_pk_bf16(v1[2], v1[3]);
                        __builtin_nontemporal_store(w, (u32x4*)(base + row * ld)); }
            } else {
#pragma unroll
                for (int ai = 0; ai < 2; ++ai)
#pragma unroll
                    for (int m = 0; m < 4; ++m) {
                        const unsigned row = (unsigned)(row0 + ai * HALF + m * 16);
                        const f32x4 v0 = acc[ai][bj][m][0], v1 = acc[ai][bj][m][1];
                        u32x4 w; w.x = cvt_pk_bf16(v0[0], v0[1]); w.y = cvt_pk_bf16(v0[2], v0[3]); w.z = cvt_pk_bf16(v1[0], v1[1]); w.w = cvt_pk_bf16(v1[2], v1[3]);
                        __builtin_nontemporal_store(w, (u32x4*)(base + row * ld)); }
                if (colw == C_IF && fq < 2) {
#pragma unroll
                    for (int ai = 0; ai < 2; ++ai)
#pragma unroll
                        for (int m = 0; m < 4; ++m) { const unsigned row = (unsigned)(row0 + ai * HALF + m * 16);
                            *(f32x4*)(side + (size_t)row * 16 + 8 * fq) = acc[ai][bj][m][0]; *(f32x4*)(side + (size_t)row * 16 + 8 * fq + 4) = acc[ai][bj][m][1]; }
                }
            }
        }
    }
};
template <int SECOND> struct EpiMerge {
    static constexpr bool PERM = true;
    bf16_t* MG; const bf16_t* GB;
    __device__ __forceinline__ void operator()(const f32x4 (&acc)[2][2][4][2], const Unit& u, int wr, int wc, int fr, int fq) const {
        const int row0 = u.pm * BM + wr * 64 + fr;
#pragma unroll
        for (int bj = 0; bj < 2; ++bj) {
            const int col = u.pn * BM + bj * HALF + wc * 32 + 8 * fq;
#pragma unroll
            for (int ai = 0; ai < 2; ++ai) {
                u32x4 ta[4], gb[4];
#pragma unroll
                for (int m = 0; m < 4; ++m) { const size_t o = (size_t)(row0 + ai * HALF + m * 16) * D + col; ta[m] = *(const u32x4*)(MG + o); if (SECOND) gb[m] = *(const u32x4*)(GB + o); }
#pragma unroll
                for (int m = 0; m < 4; ++m) {
                    const size_t o = (size_t)(row0 + ai * HALF + m * 16) * D + col;
                    const f32x4 v0 = acc[ai][bj][m][0], v1 = acc[ai][bj][m][1];
                    float r[8];
                    if (SECOND) {
                        r[0] = bflo(ta[m].x) + bflo(gb[m].x) * v0[0]; r[1] = bfhi(ta[m].x) + bfhi(gb[m].x) * v0[1]; r[2] = bflo(ta[m].y) + bflo(gb[m].y) * v0[2]; r[3] = bfhi(ta[m].y) + bfhi(gb[m].y) * v0[3];
                        r[4] = bflo(ta[m].z) + bflo(gb[m].z) * v1[0]; r[5] = bfhi(ta[m].z) + bfhi(gb[m].z) * v1[1]; r[6] = bflo(ta[m].w) + bflo(gb[m].w) * v1[2]; r[7] = bfhi(ta[m].w) + bfhi(gb[m].w) * v1[3];
                    } else {
                        r[0] = bflo(ta[m].x) * v0[0]; r[1] = bfhi(ta[m].x) * v0[1]; r[2] = bflo(ta[m].y) * v0[2]; r[3] = bfhi(ta[m].y) * v0[3];
                        r[4] = bflo(ta[m].z) * v1[0]; r[5] = bfhi(ta[m].z) * v1[1]; r[6] = bflo(ta[m].w) * v1[2]; r[7] = bfhi(ta[m].w) * v1[3]; }
                    u32x4 w; w.x = cvt_pk_bf16(r[0], r[1]); w.y = cvt_pk_bf16(r[2], r[3]); w.z = cvt_pk_bf16(r[4], r[5]); w.w = cvt_pk_bf16(r[6], r[7]);
                    *(u32x4*)(MG + o) = w; }
            }
        }
    }
};
struct EpiResid {
    static constexpr bool PERM = true;
    const bf16_t* XR; bf16_t* PRE;
    __device__ __forceinline__ void operator()(const f32x4 (&acc)[2][2][4][2], const Unit& u, int wr, int wc, int fr, int fq) const {
        const int row0 = u.pm * BM + wr * 64 + fr;
#pragma unroll
        for (int ai = 0; ai < 2; ++ai)
#pragma unroll
            for (int bj = 0; bj < 2; ++bj) { const int col = u.pn * BM + bj * HALF + wc * 32 + 8 * fq;
                u32x4 xv[4];
#pragma unroll
                for (int m = 0; m < 4; ++m) xv[m] = *(const u32x4*)(XR + (size_t)(row0 + ai * HALF + m * 16) * D + col);
#pragma unroll
                for (int m = 0; m < 4; ++m) { const u32x4 x = xv[m]; const f32x4 v0 = acc[ai][bj][m][0], v1 = acc[ai][bj][m][1];
                    u32x4 w; w.x = cvt_pk_bf16(bflo(x.x) * DN_ALPHA + v0[0], bfhi(x.x) * DN_ALPHA + v0[1]); w.y = cvt_pk_bf16(bflo(x.y) * DN_ALPHA + v0[2], bfhi(x.y) * DN_ALPHA + v0[3]);
                    w.z = cvt_pk_bf16(bflo(x.z) * DN_ALPHA + v1[0], bfhi(x.z) * DN_ALPHA + v1[1]); w.w = cvt_pk_bf16(bflo(x.w) * DN_ALPHA + v1[2], bfhi(x.w) * DN_ALPHA + v1[3]);
                    *(u32x4*)(PRE + (size_t)(row0 + ai * HALF + m * 16) * D + col) = w; } }
    }
};
struct EpiSwiglu {
    static constexpr bool PERM = true;
    bf16_t* H; int ldh;
    __device__ __forceinline__ void operator()(const f32x4 (&acc)[2][2][4][2], const Unit& u, int wr, int wc, int fr, int fq) const {
        const int row0 = u.pm * BM + wr * 64 + fr, col = u.pn * HALF + wc * 32 + 8 * fq;
#pragma unroll
        for (int ai = 0; ai < 2; ++ai)
#pragma unroll
            for (int m = 0; m < 4; ++m) {
                float r[8];
#pragma unroll
                for (int n = 0; n < 2; ++n)
#pragma unroll
                    for (int j = 0; j < 4; j += 2) { typedef float f32x2v __attribute__((ext_vector_type(2)));
                        const f32x4 ga = acc[ai][0][m][n], ua = acc[ai][1][m][n];
                        const f32x2v g = (f32x2v){ga[j], ga[j + 1]}, up = (f32x2v){ua[j], ua[j + 1]};
                        const f32x2v s = g * -1.4426950408889634f; f32x2v ex; ex.x = __builtin_amdgcn_exp2f(s.x); ex.y = __builtin_amdgcn_exp2f(s.y);
                        const f32x2v d = ex + 1.0f; f32x2v rc; rc.x = __builtin_amdgcn_rcpf(d.x); rc.y = __builtin_amdgcn_rcpf(d.y);
                        const f32x2v o = (g * up) * rc; r[4 * n + j] = o.x; r[4 * n + j + 1] = o.y; }
                u32x4 w; w.x = cvt_pk_bf16(r[0], r[1]); w.y = cvt_pk_bf16(r[2], r[3]); w.z = cvt_pk_bf16(r[4], r[5]); w.w = cvt_pk_bf16(r[6], r[7]);
                __builtin_nontemporal_store(w, (u32x4*)(H + (size_t)(row0 + ai * HALF + m * 16) * ldh + col)); }
    }
};
struct EpiMoeDown {
    static constexpr bool PERM = true;
    bf16_t* Y; const float* rg;
    __device__ __forceinline__ void operator()(const f32x4 (&acc)[2][2][4][2], const Unit& u, int wr, int wc, int fr, int fq) const {
        const int row0 = u.pm * BM + wr * 64 + fr;
#pragma unroll
        for (int ai = 0; ai < 2; ++ai)
#pragma unroll
            for (int m = 0; m < 4; ++m) { const int row = row0 + ai * HALF + m * 16; const float gsc = rg[row];
#pragma unroll
                for (int bj = 0; bj < 2; ++bj) { const int col = u.pn * BM + bj * HALF + wc * 32 + 8 * fq;
                    const f32x4 v0 = acc[ai][bj][m][0] * gsc, v1 = acc[ai][bj][m][1] * gsc;
                    u32x4 w; w.x = cvt_pk_bf16(v0[0], v0[1]); w.y = cvt_pk_bf16(v0[2], v0[3]); w.z = cvt_pk_bf16(v1[0], v1[1]); w.w = cvt_pk_bf16(v1[2], v1[3]);
                    *(u32x4*)(Y + (size_t)row * D + col) = w; } }
    }
};
}

struct Args { const float* in[21]; float* out; unsigned char* ws; int ph_lo, ph_hi; };
typedef const Args __attribute__((address_space(4)))* CArgs;
struct Frame {
    LAS unsigned char* lds;
    int tid, lane, wave, vcu, G, gw, NGW;
    CArgs ap; float* out; unsigned char* ws;
};
enum { I_X = 0, I_WIN, I_CONVW, I_GBIAS, I_NORMG, I_KVNG, I_WUK, I_WUV, I_RELB, I_WBA, I_WBB, I_WOUT, I_LNG, I_LNB, I_DWG, I_DWU, I_DWD, I_RW, I_EWG, I_EWU, I_EWD };

template <class F>
__device__ __forceinline__ void transpose_item(const F& val, int K, bf16_t* WT, LAS float* scr, int k0, int n0, int lane) {
#pragma unroll
    for (int i0 = 0; i0 < 32; i0 += 16) {
        float tv[16];
#pragma unroll
        for (int i = 0; i < 16; ++i) tv[i] = val(k0 + 2 * (i0 + i) + (lane >> 5), n0 + (lane & 31));
#pragma unroll
        for (int i = 0; i < 16; ++i) scr[(2 * (i0 + i) + (lane >> 5)) * 33 + (lane & 31)] = tv[i];
    }
    LDS_WAIT(); asm volatile("" ::: "memory");
    const int c = lane & 7;
#pragma unroll
    for (int j = 0; j < 4; ++j) { const int n = (lane >> 3) + 8 * j; const LAS float* s = scr + (8 * c) * 33 + n;
        u32x4 o; o.x = pk2(s[0 * 33], s[1 * 33]); o.y = pk2(s[2 * 33], s[3 * 33]); o.z = pk2(s[4 * 33], s[5 * 33]); o.w = pk2(s[6 * 33], s[7 * 33]);
        *(u32x4*)(WT + (size_t)(n0 + n) * K + k0 + 8 * c) = o; }
    LDS_WAIT(); asm volatile("" ::: "memory");
}
struct ValPlain { const float* W; int ldw; __device__ __forceinline__ float operator()(int k, int n) const { return W[(size_t)k * ldw + n]; }
    __device__ __forceinline__ f32x4 val4(int k, int n) const { return __builtin_nontemporal_load((const f32x4*)(W + (size_t)k * ldw + n)); } };
struct ValInProj { const float* W; const float* uk;
    __device__ __forceinline__ float operator()(int k, int c) const {
        const float* wr = W + (size_t)k * DIN;
        if (c < C_QL) return wr[c];
        if (c < C_BC) { const int h = (c - C_QL) >> 7, cc = (c - C_QL) & 127; const float* a = wr + 1544 + 64 * h; const float* b = uk + (size_t)h * 64 * 128 + cc; float s = 0.f;
#pragma unroll 8
            for (int d = 0; d < 64; ++d) s += a[d] * b[d * 128]; return s; }
        if (c < C_IQ) return wr[2056 + (c - C_BC)];
        if (c < C_IK) return wr[2184 + (c - C_IQ)];
        if (c < C_GA) return wr[2440 + (c - C_IK)];
        if (c < C_GB) return wr[2480 + (c - C_GA)];
        if (c < C_IF) return wr[3504 + (c - C_GB)];
        if (c < C_IW) return wr[1536 + (c - C_IF)];
        if (c < C_END) return wr[2472 + (c - C_IW)];
        return 0.f; } };
struct ValOB { const float* uv; const float* wb;
    __device__ __forceinline__ float operator()(int k, int n) const { const int h = k >> 7; const float* a = uv + (size_t)k * 64; const float* b = wb + (size_t)(64 * h) * D + n; float s = 0.f;
#pragma unroll 8
        for (int d = 0; d < 64; ++d) s += a[d] * b[(size_t)d * D]; return s; } };
struct ValGU { const float* Wg; const float* Wu; int dff;
    __device__ __forceinline__ float operator()(int k, int n) const { const int pn = n >> 8, rr = n & 255; const int col = 128 * pn + (rr & 127); const long dlt = (rr < 128) ? 0l : (long)(Wu - Wg); return Wg[dlt + (long)k * dff + col]; }
    __device__ __forceinline__ f32x4 val4(int k, int n) const { const int pn = n >> 8, rr = n & 255; const int col = 128 * pn + (rr & 127); const long dlt = (rr < 128) ? 0l : (long)(Wu - Wg); return __builtin_nontemporal_load((const f32x4*)(Wg + dlt + (long)k * dff + col)); } };

template <class F>
__device__ __forceinline__ void convert_matrix(Frame& F_, const F& val, int K, int N, bf16_t* WT, int& item_base) {
    LAS float* scr = (LAS float*)(F_.lds + F_.wave * 16384);
    const int nkb = K / 64, nnb = N / 32, nitems = nkb * nnb;
    int first = F_.gw - (item_base % F_.NGW); if (first < 0) first += F_.NGW;
    for (int it = first; it < nitems; it += F_.NGW) { const int kb = it / nnb, nb = it % nnb; transpose_item(val, K, WT, scr, 64 * kb, 32 * nb, F_.lane); }
    item_base += nitems;
}

template <class F>
__device__ __forceinline__ void transpose_item64(const F& val, int K, bf16_t* WT, LAS float* scr, int k0, int n0, int lane) {
    const int nq = 4 * (lane & 15), kr = lane >> 4;
#pragma unroll
    for (int h = 0; h < 2; ++h) {
        f32x4 tv[8];
#pragma unroll
        for (int i = 0; i < 8; ++i) tv[i] = val.val4(k0 + 4 * (8 * h + i) + kr, n0 + nq);
#pragma unroll
        for (int i = 0; i < 8; ++i) { LAS float* d = scr + (4 * (8 * h + i) + kr) * 65 + nq; d[0] = tv[i][0]; d[1] = tv[i][1]; d[2] = tv[i][2]; d[3] = tv[i][3]; }
    }
    LDS_WAIT(); asm volatile("" ::: "memory");
    const int c = lane & 7;
#pragma unroll
    for (int j = 0; j < 8; ++j) { const int n = (lane >> 3) + 8 * j; const LAS float* s = scr + (8 * c) * 65 + n;
        u32x4 o; o.x = pk2(s[0 * 65], s[1 * 65]); o.y = pk2(s[2 * 65], s[3 * 65]); o.z = pk2(s[4 * 65], s[5 * 65]); o.w = pk2(s[6 * 65], s[7 * 65]);
        *(u32x4*)(WT + (size_t)(n0 + n) * K + k0 + 8 * c) = o; }
    LDS_WAIT(); asm volatile("" ::: "memory");
}
template <class F>
__device__ __forceinline__ void convert_matrix64(Frame& F_, const F& val, int K, int N, bf16_t* WT, int& item_base) {
    LAS float* scr = (LAS float*)(F_.lds + F_.wave * 16640);
    const int nkb = K / 64, nnb = N / 64, nitems = nkb * nnb;
    int first = F_.gw - (item_base % F_.NGW); if (first < 0) first += F_.NGW;
    for (int it = first; it < nitems; it += F_.NGW) { const int kb = it / nnb, nb = it % nnb; transpose_item64(val, K, WT, scr, 64 * kb, 64 * nb, F_.lane); }
    item_base += nitems;
}

template <int MODE, bool ROUTE>
__device__ __forceinline__ void ln_pass(Frame& F, int l, int which, int hf, const bf16_t* ys, const unsigned* tdest) {
    const float* g = F.ap->in[I_LNG] + (size_t)(l * 2 + which) * D; const float* b = F.ap->in[I_LNB] + (size_t)(l * 2 + which) * D;
    const bool whole = (hf == 2); if (whole) hf = 0;
    const int nrows = whole ? 2 * MH : MH;
    bf16_t* xb = (bf16_t*)(F.ws + WS_XB); const bf16_t* pre = (const bf16_t*)(F.ws + (whole ? WS_PRE2 : WS_PRE));
    const bool final_out = (l == DEPTH - 1) && (which == 1);
    LAS float* rw = (LAS float*)F.lds;
    LAS unsigned* lcnt = (LAS unsigned*)(F.lds + 32768);
    if (ROUTE) {
        const float* RW = F.ap->in[I_RW] + (size_t)(l >> 1) * D * NEXP;
        for (int idx = F.tid; idx < D * NEXP; idx += 512) { const int k = idx >> 3, e = idx & 7; rw[((((k >> 8) * 4 + (k & 3)) * 64 + ((k & 255) >> 2)) << 3) + e] = RW[idx]; }
        if (F.tid < 8) lcnt[F.tid] = 0u;
        __syncthreads();
    }
    f32x4 gv[4], bv[4];
#pragma unroll
    for (int j = 0; j < 4; ++j) { gv[j] = *(const f32x4*)(g + 4 * F.lane + 256 * j); bv[j] = *(const f32x4*)(b + 4 * F.lane + 256 * j); }
    for (int r = F.gw; r < nrows; r += F.NGW) {
        const size_t grow = (size_t)hf * MH + r;
        f32x4 v[4]; float s = 0.f;
        if (MODE == 0) {
#pragma unroll
            for (int j = 0; j < 4; ++j) { const u32x2 a = *(const u32x2*)(pre + (size_t)r * D + 4 * F.lane + 256 * j); v[j] = (f32x4){bflo(a.x), bfhi(a.x), bflo(a.y), bfhi(a.y)}; }
        } else {
            const unsigned d0 = tdest[2 * r], d1 = tdest[2 * r + 1];
            const bf16_t* y0 = ys + (size_t)d0 * D + 4 * F.lane; const bf16_t* y1 = ys + (size_t)d1 * D + 4 * F.lane; const bf16_t* xr = xb + grow * D + 4 * F.lane;
#pragma unroll
            for (int j = 0; j < 4; ++j) { const u32x2 a = *(const u32x2*)(y0 + 256 * j), c = *(const u32x2*)(y1 + 256 * j), x = *(const u32x2*)(xr + 256 * j);
                v[j][0] = bflo(x.x) * DN_ALPHA + (bflo(a.x) + bflo(c.x)); v[j][1] = bfhi(x.x) * DN_ALPHA + (bfhi(a.x) + bfhi(c.x));
                v[j][2] = bflo(x.y) * DN_ALPHA + (bflo(a.y) + bflo(c.y)); v[j][3] = bfhi(x.y) * DN_ALPHA + (bfhi(a.y) + bfhi(c.y)); }
        }
#pragma unroll
        for (int j = 0; j < 4; ++j) s += (v[j][0] + v[j][1]) + (v[j][2] + v[j][3]);
        const float mean = wave_sum(s) * (1.f / D); float s2 = 0.f;
#pragma unroll
        for (int j = 0; j < 4; ++j) { v[j] = v[j] - mean; s2 += (v[j][0] * v[j][0] + v[j][1] * v[j][1]) + (v[j][2] * v[j][2] + v[j][3] * v[j][3]); }
        const float rstd = __builtin_amdgcn_rsqf(wave_sum(s2) * (1.f / D) + LN_EPS);
#pragma unroll
        for (int j = 0; j < 4; ++j) { v[j] = v[j] * rstd * gv[j] + bv[j];
            if (final_out) *(f32x4*)(F.out + grow * D + 4 * F.lane + 256 * j) = v[j];
            u32x2 w; w.x = cvt_pk_bf16(v[j][0], v[j][1]); w.y = cvt_pk_bf16(v[j][2], v[j][3]); *(u32x2*)(xb + grow * D + 4 * F.lane + 256 * j) = w; }
        if (ROUTE) {
            float lg[8];
#pragma unroll
            for (int e = 0; e < 8; ++e) lg[e] = 0.f;
#pragma unroll
            for (int j = 0; j < 4; ++j)
#pragma unroll
                for (int i = 0; i < 4; ++i) { const LAS float* w = rw + (((j * 4 + i) * 64 + F.lane) << 3); const f32x4 w0 = *(const LAS f32x4*)w, w1 = *(const LAS f32x4*)(w + 4); const float xv = v[j][i];
                    lg[0] += xv * w0[0]; lg[1] += xv * w0[1]; lg[2] += xv * w0[2]; lg[3] += xv * w0[3]; lg[4] += xv * w1[0]; lg[5] += xv * w1[1]; lg[6] += xv * w1[2]; lg[7] += xv * w1[3]; }
            {
                float h4[4], w2[2];
#pragma unroll
                for (int e = 0; e < 4; ++e) { auto s = __builtin_amdgcn_permlane32_swap(__float_as_uint(lg[e]), __float_as_uint(lg[e + 4]), false, false); const unsigned s0 = s[0], s1 = s[1]; h4[e] = __uint_as_float(s0) + __uint_as_float(s1); }
#pragma unroll
                for (int i = 0; i < 2; ++i) { auto s = __builtin_amdgcn_permlane16_swap(__float_as_uint(h4[i]), __float_as_uint(h4[i + 2]), false, false); const unsigned s0 = s[0], s1 = s[1]; w2[i] = row16_sum(__uint_as_float(s0) + __uint_as_float(s1)); }
#pragma unroll
                for (int i = 0; i < 2; ++i) {
                    lg[i] = __uint_as_float(__builtin_amdgcn_readlane(__float_as_uint(w2[i]), 0)); lg[2 + i] = __uint_as_float(__builtin_amdgcn_readlane(__float_as_uint(w2[i]), 16));
                    lg[4 + i] = __uint_as_float(__builtin_amdgcn_readlane(__float_as_uint(w2[i]), 32)); lg[6 + i] = __uint_as_float(__builtin_amdgcn_readlane(__float_as_uint(w2[i]), 48)); }
            }
            int e1 = 0; float l1 = lg[0];
#pragma unroll
            for (int e = 1; e < 8; ++e) if (lg[e] > l1) { l1 = lg[e]; e1 = e; }
            int e2 = -1; float l2 = -3.0e38f;
#pragma unroll
            for (int e = 0; e < 8; ++e) if (e != e1 && lg[e] > l2) { l2 = lg[e]; e2 = e; }
            if (F.lane == 0) {
                const float t = __expf(l2 - l1), p1 = 1.f / (1.f + t), p2 = t / (1.f + t);
                ((unsigned*)(F.ws + WS_MISC + MS_TE))[r] = (unsigned)e1 | ((unsigned)e2 << 8);
                ((float*)(F.ws + WS_MISC + MS_TG))[2 * r] = p1; ((float*)(F.ws + WS_MISC + MS_TG))[2 * r + 1] = p2;
                atomicAdd((unsigned*)(lcnt + e1), 1u); atomicAdd((unsigned*)(lcnt + e2), 1u);
            }
        }
    }
    if (ROUTE) { __syncthreads(); if (F.tid < 8) ((unsigned*)(F.ws + WS_MISC + MS_WGC))[F.vcu * 8 + F.tid] = lcnt[F.tid]; }
}

__device__ __forceinline__ void moe_scatter(Frame& F, int hf) {
    LAS unsigned* sh = (LAS unsigned*)F.lds;
    const unsigned* wgc = (const unsigned*)(F.ws + WS_MISC + MS_WGC);
    if (F.tid < 8) { unsigned tot = 0, mine = 0; for (int g = 0; g < F.G; ++g) { const unsigned c = wgc[g * 8 + F.tid]; if (g == F.vcu) mine = tot; tot += c; } sh[16 + F.tid] = tot; sh[F.tid] = mine; sh[8 + F.tid] = 0u; }
    __syncthreads();
    if (F.tid == 0) { unsigned ps = 0; for (int e = 0; e < 8; ++e) { sh[24 + e] = ps; sh[e] += ps; ps += ((sh[16 + e] + 255u) >> 8) << 8; }
        if (F.vcu == 0) { unsigned* meta = (unsigned*)(F.ws + WS_MISC + MS_META); meta[0] = ps >> 8;
            for (int e = 0; e < 8; ++e) { const unsigned b0 = sh[24 + e] >> 8, nb = (sh[16 + e] + 255u) >> 8; for (unsigned j = 0; j < nb; ++j) meta[16 + b0 + j] = (unsigned)e; } } }
    __syncthreads();
    const unsigned* te = (const unsigned*)(F.ws + WS_MISC + MS_TE); const float* tg = (const float*)(F.ws + WS_MISC + MS_TG);
    unsigned* td = (unsigned*)(F.ws + WS_MISC + MS_TD); float* rg = (float*)(F.ws + WS_MISC + MS_RG);
    const bf16_t* xb = (const bf16_t*)(F.ws + WS_XB); bf16_t* xs = (bf16_t*)(F.ws + WS_XS);
    for (int r = F.gw; r < MH; r += F.NGW) {
        const unsigned ee = te[r]; const int e1 = ee & 255, e2 = (ee >> 8) & 255;
        unsigned d0 = 0, d1 = 0;
        if (F.lane == 0) { d0 = sh[e1] + atomicAdd((unsigned*)(sh + 8 + e1), 1u); d1 = sh[e2] + atomicAdd((unsigned*)(sh + 8 + e2), 1u);
            td[2 * r] = d0; td[2 * r + 1] = d1; rg[d0] = tg[2 * r]; rg[d1] = tg[2 * r + 1]; }
        d0 = __builtin_amdgcn_readfirstlane(d0); d1 = __builtin_amdgcn_readfirstlane(d1);
        const bf16_t* src = xb + ((size_t)hf * MH + r) * D + 16 * F.lane;
        const u32x4 a = *(const u32x4*)src, c = *(const u32x4*)(src + 8);
        *(u32x4*)(xs + (size_t)d0 * D + 16 * F.lane) = a; *(u32x4*)(xs + (size_t)d0 * D + 16 * F.lane + 8) = c;
        *(u32x4*)(xs + (size_t)d1 * D + 16 * F.lane) = a; *(u32x4*)(xs + (size_t)d1 * D + 16 * F.lane + 8) = c;
    }
}

__device__ __forceinline__ f32x4 mma16(const LAS bf16_t* A, int lda, const LAS bf16_t* Bt, int ldb, int ksteps, int lane) {
    f32x4 acc = (f32x4){0.f, 0.f, 0.f, 0.f};
    const LAS bf16_t* ap = A + (lane & 15) * lda + 8 * (lane >> 4);
    const LAS bf16_t* bp = Bt + (lane & 15) * ldb + 8 * (lane >> 4);
    for (int ks = 0; ks < ksteps; ++ks) {
        const bf16x8 a = *(const LAS bf16x8*)(ap + 32 * ks), b = *(const LAS bf16x8*)(bp + 32 * ks);
        acc = __builtin_amdgcn_mfma_f32_16x16x32_bf16(a, b, acc, 0, 0, 0);
    }
    return acc;
}
__device__ __forceinline__ float log_sigmoidf_(float x) { return fminf(x, 0.f) - log1pf(__expf(-fabsf(x))); }
__device__ __forceinline__ float siluf_(float x) { return x * sigmoidf_(x); }

__device__ __forceinline__ void conv8(const bf16_t* proj, const float* cw  , int row, int tseq, int ch0, float (&o)[8]) {
#pragma unroll
    for (int i = 0; i < 8; ++i) o[i] = 0.f;
#pragma unroll
    for (int j = 0; j < 4; ++j) {
        if (tseq - 3 + j >= 0) {
            const u32x4 v = *(const u32x4*)(proj + (size_t)(row - 3 + j) * NP + C_QK + ch0);
            const f32x4 w0 = *(const f32x4*)(cw + j * 512 + ch0), w1 = *(const f32x4*)(cw + j * 512 + ch0 + 4);
            o[0] += bflo(v.x) * w0[0]; o[1] += bfhi(v.x) * w0[1]; o[2] += bflo(v.y) * w0[2]; o[3] += bfhi(v.y) * w0[3];
            o[4] += bflo(v.z) * w1[0]; o[5] += bfhi(v.z) * w1[1]; o[6] += bflo(v.w) * w1[2]; o[7] += bfhi(v.w) * w1[3];
        }
    }
#pragma unroll
    for (int i = 0; i < 8; ++i) o[i] = siluf_(o[i]);
}

__device__ __forceinline__ size_t skv_idx(int u, int e) { return ((size_t)(((u >> 7) * 16 + (e >> 9)) * 128 + (u & 127))) * 512 + (e & 511); }
__device__ __forceinline__ void mlstm_local(Frame& F, int l) {
    const bf16_t* proj = (const bf16_t*)(F.ws + WS_PROJ); const float* side = (const float*)(F.ws + WS_SIDE);
    bf16_t* skv = (bf16_t*)(F.ws + WS_SKV); float* sn = (float*)(F.ws + WS_SN); float* ssc = (float*)(F.ws + WS_SSC);
    const float* cw = F.ap->in[I_CONVW] + (size_t)l * 4 * 512; const float* gbias = F.ap->in[I_GBIAS] + l * 8;
    LAS bf16_t* Vt = (LAS bf16_t*)F.lds;
    LAS bf16_t* Kwt = (LAS bf16_t*)(F.lds + 18432);
    LAS float* wsc = (LAS float*)(F.lds + 27648);
    const int lane = F.lane, g4 = lane >> 4;
    for (int u = F.vcu; u < 2048; u += F.G) {
        const int seq = u >> 7, c = u & 127, lb = seq >> 2, hd = seq & 3, r0 = lb * SEQ + 64 * c;
        if (F.wave == 0) {
            const int row = r0 + lane;
            const float ig = side[(size_t)row * 16 + hd] + gbias[hd];
            const float lf = log_sigmoidf_(side[(size_t)row * 16 + 4 + hd] + gbias[4 + hd]);
            float b = lf;
#pragma unroll
            for (int o = 1; o < 64; o <<= 1) { const float t = __shfl_up(b, o); if (lane >= o) b += t; }
            const float blast = __shfl(b, 63);
            const float gl = blast - b + ig;
            float mx = gl;
#pragma unroll
            for (int o = 1; o < 64; o <<= 1) mx = fmaxf(mx, __shfl_xor(mx, o));
            wsc[lane] = __expf(gl - mx);
            if (lane == 0) { ssc[u * 4 + 0] = mx; ssc[u * 4 + 1] = blast; }
        }
        __syncthreads();
        {
            const int s = F.tid >> 3, d8 = (F.tid & 7) * 8; float kv[8];
            conv8(proj, cw, r0 + s, 64 * c + s, 256 + hd * 64 + d8, kv);
            const float sc = 0.125f * wsc[s];
#pragma unroll
            for (int i = 0; i < 8; ++i) Kwt[(d8 + i) * 72 + s] = (bf16_t)f2bf(kv[i] * sc);
            const int v16 = (F.tid & 7) * 16;
            const u32x4 a = *(const u32x4*)(proj + (size_t)(r0 + s) * NP + C_V + hd * 128 + v16), b2 = *(const u32x4*)(proj + (size_t)(r0 + s) * NP + C_V + hd * 128 + v16 + 8);
            const unsigned w[8] = {a.x, a.y, a.z, a.w, b2.x, b2.y, b2.z, b2.w};
#pragma unroll
            for (int i = 0; i < 8; ++i) { Vt[(v16 + 2 * i) * 72 + s] = (bf16_t)(w[i] & 0xffffu); Vt[(v16 + 2 * i + 1) * 72 + s] = (bf16_t)(w[i] >> 16); }
        }
        __syncthreads();
        {
            const int w = F.wave;
            LAS float* stg = (LAS float*)(F.lds + 32768);
#pragma unroll
            for (int dt = 0; dt < 4; ++dt) {
                const f32x4 acc = mma16(Vt + 16 * w * 72, 72, Kwt + 16 * dt * 72, 72, 2, lane);
#pragma unroll
                for (int j = 0; j < 4; ++j) stg[(16 * w + 4 * g4 + j) * 64 + 16 * dt + (lane & 15)] = acc[j];
            }
            if (F.tid < 64) { float s = 0.f; for (int i = 0; i < 64; ++i) s += bf2f(Kwt[F.tid * 72 + i]); sn[u * 64 + F.tid] = s; }
            __syncthreads();
#pragma unroll
            for (int k = 0; k < 2; ++k) { const int e8 = 8 * (F.tid + 512 * k); const f32x4 a = *(const LAS f32x4*)(stg + e8), b = *(const LAS f32x4*)(stg + e8 + 4);
                *(u32x4*)(skv + skv_idx(u, e8)) = (u32x4){pk2(a[0], a[1]), pk2(a[2], a[3]), pk2(b[0], b[1]), pk2(b[2], b[3])}; }
        }
        __syncthreads();
    }
}

template <bool DUMMY>
__device__ __forceinline__ void mlstm_scan_t(Frame& F) {
    bf16_t* skv = (bf16_t*)(F.ws + WS_SKV); float* sn = (float*)(F.ws + WS_SN); float* ssc = (float*)(F.ws + WS_SSC);
    typedef float f32x2 __attribute__((ext_vector_type(2)));
    LAS f32x2* coef = (LAS f32x2*)F.lds;
    LAS float* raw = (LAS float*)(F.lds + 1024);
    for (int g0 = F.vcu * 512; g0 < 16 * 8192; g0 += F.G * 512) {
        const int seq = __builtin_amdgcn_readfirstlane(g0 >> 13), eb = g0 & 8191;
        const int e2 = eb + 2 * (F.tid & 255);
        unsigned* kvp = (unsigned*)(skv + skv_idx(seq * 128, e2)); float* snp = sn + (size_t)seq * 128 * 64 + (F.tid & 63); float* scp = ssc + (size_t)seq * 128 * 4;
        constexpr int UB = 16;
        unsigned kvA[UB], kvB[UB];
        if (F.tid < 256) {
#pragma unroll
            for (int i = 0; i < UB; ++i) kvA[i] = kvp[(size_t)i * 256]; }
        __syncthreads();
        if (F.tid < 128) { raw[2 * F.tid] = scp[F.tid * 4 + 0]; raw[2 * F.tid + 1] = scp[F.tid * 4 + 1]; }
        __syncthreads();
        if (F.tid == 0) { float m = 0.f;
            for (int c = 0; c < 128; ++c) { const float ml = raw[2 * c], bl = raw[2 * c + 1]; const float mn = fmaxf(bl + m, ml);
                coef[c] = (f32x2){__expf(bl + m - mn), __expf(ml - mn)}; if (!DUMMY && eb == 0) scp[c * 4 + 2] = m; m = mn; } }
        __syncthreads();
        if (F.tid < 256) {
            float C0 = 0.f, C1 = 0.f;
#define SCAN_BATCH(CUR, NXT, c0) do { \
            if ((c0) + UB < 128) { _Pragma("unroll") for (int i = 0; i < UB; ++i) NXT[i] = kvp[(size_t)((c0) + UB + i) * 256]; } \
            _Pragma("unroll") for (int i = 0; i < UB; ++i) { const int c = (c0) + i; const f32x2 cf = coef[c]; \
                (DUMMY ? kvp + (960 * MiB - WS_SKV) / 4 : kvp)[(size_t)c * 256] = pk2(C0, C1); C0 = cf.x * C0 + cf.y * bflo(CUR[i]); C1 = cf.x * C1 + cf.y * bfhi(CUR[i]); } } while (0)
            for (int c0 = 0; c0 < 128; c0 += 2 * UB) { SCAN_BATCH(kvA, kvB, c0); SCAN_BATCH(kvB, kvA, c0 + UB); }
#undef SCAN_BATCH
        } else if (!DUMMY && F.tid < 320 && eb == 0) {
            float n = 0.f, nv[16];
            for (int c0 = 0; c0 < 128; c0 += 16) {
#pragma unroll
                for (int i = 0; i < 16; ++i) nv[i] = snp[(c0 + i) * 64];
#pragma unroll
                for (int i = 0; i < 16; ++i) { const f32x2 cf = coef[c0 + i]; snp[(c0 + i) * 64] = n; n = cf.x * n + cf.y * nv[i]; } }
        }
    }
}

__device__ __forceinline__ void mlstm_scan(Frame& F) { mlstm_scan_t<false>(F); }

__device__ __forceinline__ void mlstm_out(Frame& F, int l) {
    bf16_t* proj = (bf16_t*)(F.ws + WS_PROJ); const float* side = (const float*)(F.ws + WS_SIDE);
    const bf16_t* skv = (const bf16_t*)(F.ws + WS_SKV); const float* sn = (const float*)(F.ws + WS_SN); const float* ssc = (const float*)(F.ws + WS_SSC);
    const float* cw = F.ap->in[I_CONVW] + (size_t)l * 4 * 512; const float* gbias = F.ap->in[I_GBIAS] + l * 8; const float* ng = F.ap->in[I_NORMG] + (size_t)l * 512;
    LAS bf16_t* Qs = (LAS bf16_t*)F.lds;
    LAS bf16_t* Ks = (LAS bf16_t*)(F.lds + 9216);
    LAS bf16_t* Sw = (LAS bf16_t*)(F.lds + 18432);
    LAS bf16_t* Vt = (LAS bf16_t*)(F.lds + 27648);
    LAS bf16_t* Ct = (LAS bf16_t*)(F.lds + 48384);
    LAS float* Hr = (LAS float*)(F.lds + 69120);
    LAS float* gB = (LAS float*)(F.lds + 107008);
    LAS float* gA = gB + 64;
    LAS float* gM = gB + 128;
    LAS float* gW = gB + 192;
    LAS float* gE = gB + 256;
    const int lane = F.lane, g4 = lane >> 4;
    for (int u = F.vcu; u < 2048; u += F.G) {
        const int seq = u >> 7, c = u & 127, lb = seq >> 2, hd = seq & 3, r0 = lb * SEQ + 64 * c;
        if (F.wave == 0) {
            const int row = r0 + lane;
            const float ig = side[(size_t)row * 16 + hd] + gbias[hd];
            const float lf = log_sigmoidf_(side[(size_t)row * 16 + 4 + hd] + gbias[4 + hd]);
            float b = lf;
#pragma unroll
            for (int o = 1; o < 64; o <<= 1) { const float t = __shfl_up(b, o); if (lane >= o) b += t; }
            const float a = ig - b;
            float pm = a;
#pragma unroll
            for (int o = 1; o < 64; o <<= 1) { const float t = __shfl_up(pm, o); if (lane >= o) pm = fmaxf(pm, t); }
            const float mst = ssc[u * 4 + 2];
            const float mt = fmaxf(b + mst, b + pm);
            gB[lane] = b; gA[lane] = a; gM[lane] = mt; gW[lane] = __expf(b + mst - mt); gE[lane] = __expf(-mt);
        }
        {
            const int s = F.tid >> 3, d8 = (F.tid & 7) * 8; float qv[8], kv[8];
            conv8(proj, cw, r0 + s, 64 * c + s, hd * 64 + d8, qv);
            conv8(proj, cw, r0 + s, 64 * c + s, 256 + hd * 64 + d8, kv);
            u32x4 wq, wk; wq.x = pk2(qv[0], qv[1]); wq.y = pk2(qv[2], qv[3]); wq.z = pk2(qv[4], qv[5]); wq.w = pk2(qv[6], qv[7]);
            wk.x = pk2(kv[0] * 0.125f, kv[1] * 0.125f); wk.y = pk2(kv[2] * 0.125f, kv[3] * 0.125f); wk.z = pk2(kv[4] * 0.125f, kv[5] * 0.125f); wk.w = pk2(kv[6] * 0.125f, kv[7] * 0.125f);
            *(LAS u32x4*)(Qs + s * 72 + d8) = wq; *(LAS u32x4*)(Ks + s * 72 + d8) = wk;
            const int v16 = (F.tid & 7) * 16;
            const u32x4 a = *(const u32x4*)(proj + (size_t)(r0 + s) * NP + C_V + hd * 128 + v16), b2 = *(const u32x4*)(proj + (size_t)(r0 + s) * NP + C_V + hd * 128 + v16 + 8);
            const unsigned w[8] = {a.x, a.y, a.z, a.w, b2.x, b2.y, b2.z, b2.w};
#pragma unroll
            for (int i = 0; i < 8; ++i) { Vt[(v16 + 2 * i) * 72 + s] = (bf16_t)(w[i] & 0xffffu); Vt[(v16 + 2 * i + 1) * 72 + s] = (bf16_t)(w[i] >> 16); }
            for (int i = F.tid; i < 16 * 64; i += 512) { const int rr = 128 + (i >> 6), cc = i & 63; Vt[rr * 72 + cc] = (bf16_t)(rr == 128 ? 0x3F80u : 0u); Ct[rr * 72 + cc] = (bf16_t)(rr == 128 ? f2bf(sn[u * 64 + cc]) : 0u); }
            const int v = F.tid >> 2, d16 = (F.tid & 3) * 16; const bf16_t* cp = skv + skv_idx(u, v * 64 + d16);
            const u32x4 o0 = *(const u32x4*)cp, o1 = *(const u32x4*)(cp + 8);
            *(LAS u32x4*)(Ct + v * 72 + d16) = o0; *(LAS u32x4*)(Ct + v * 72 + d16 + 8) = o1;
        }
        __syncthreads();
        {
            const int tt = F.wave >> 1;
#pragma unroll
            for (int i = 0; i < 2; ++i) { const int st = 2 * (F.wave & 1) + i;
                f32x4 acc = (f32x4){0.f, 0.f, 0.f, 0.f};
                if (st <= tt) acc = mma16(Qs + 16 * tt * 72, 72, Ks + 16 * st * 72, 72, 2, lane);
                const int s = 16 * st + (lane & 15); const float as = gA[s];
#pragma unroll
                for (int j = 0; j < 4; ++j) { const int t = 16 * tt + 4 * g4 + j; const float val = (s <= t) ? acc[j] * __expf(gB[t] - gM[t] + as) : 0.f; Sw[t * 72 + s] = (bf16_t)f2bf(val); } }
        }
        __syncthreads();
        {
            const int tt = F.wave & 3, v0 = (F.wave < 4) ? 0 : 5, v1 = (F.wave < 4) ? 5 : 9;
            for (int vt = v0; vt < v1; ++vt) {
                const f32x4 a1 = mma16(Sw + 16 * tt * 72, 72, Vt + 16 * vt * 72, 72, 2, lane);
                const f32x4 a2 = mma16(Qs + 16 * tt * 72, 72, Ct + 16 * vt * 72, 72, 2, lane);
#pragma unroll
                for (int j = 0; j < 4; ++j) { const int t = 16 * tt + 4 * g4 + j; Hr[t * 148 + 16 * vt + (lane & 15)] = a1[j] + gW[t] * a2[j]; } }
        }
        __syncthreads();
        {
            const int t = F.tid >> 3, v16 = (F.tid & 7) * 16;
            const float den = Hr[t * 148 + 128], dd = fmaxf(fabsf(den), gE[t]), inv = __builtin_amdgcn_rcpf(dd);
            float h[16], s = 0.f;
#pragma unroll
            for (int i = 0; i < 16; ++i) { h[i] = Hr[t * 148 + v16 + i] * inv; s += h[i]; }
            s += __shfl_xor(s, 1); s += __shfl_xor(s, 2); s += __shfl_xor(s, 4);
            const float mu = s * (1.f / 128.f); float q = 0.f;
#pragma unroll
            for (int i = 0; i < 16; ++i) { h[i] -= mu; q += h[i] * h[i]; }
            q += __shfl_xor(q, 1); q += __shfl_xor(q, 2); q += __shfl_xor(q, 4);
            const float rstd = __builtin_amdgcn_rsqf(q * (1.f / 128.f) + LN_EPS);
            bf16_t* rowp = proj + (size_t)(r0 + t) * NP;
            const u32x4 ao0 = *(const u32x4*)(rowp + C_O + hd * 128 + v16), ao1 = *(const u32x4*)(rowp + C_O + hd * 128 + v16 + 8);
            const unsigned aw[8] = {ao0.x, ao0.y, ao0.z, ao0.w, ao1.x, ao1.y, ao1.z, ao1.w};
            unsigned ow[8];
#pragma unroll
            for (int i = 0; i < 8; ++i) { const float y0 = h[2 * i] * rstd * ng[hd * 128 + v16 + 2 * i] * sigmoidf_(bflo(aw[i])), y1 = h[2 * i + 1] * rstd * ng[hd * 128 + v16 + 2 * i + 1] * sigmoidf_(bfhi(aw[i])); ow[i] = EXP_ZERO_MLSTM ? 0u : pk2(y0, y1); }
            bf16_t* yp = (bf16_t*)(F.ws + WS_YA) + (size_t)(r0 + t) * 512 + hd * 128 + v16;
            *(u32x4*)yp = (u32x4){ow[0], ow[1], ow[2], ow[3]}; *(u32x4*)(yp + 8) = (u32x4){ow[4], ow[5], ow[6], ow[7]};
        }
        __syncthreads();
    }
}

__device__ __forceinline__ void ckv_pass(Frame& F, int l) {
    const bf16_t* proj = (const bf16_t*)(F.ws + WS_PROJ); bf16_t* ckv = (bf16_t*)(F.ws + WS_CKV); bf16_t* ikp = (bf16_t*)(F.ws + WS_IKP);
    const float* kg = F.ap->in[I_KVNG] + (size_t)l * 128;
    const int l16 = F.lane & 15, rs = F.lane >> 4;
    const f32x4 g0 = *(const f32x4*)(kg + 8 * l16), g1 = *(const f32x4*)(kg + 8 * l16 + 4);
    for (int r4 = F.gw; r4 < MH / 4; r4 += F.NGW) {
        const int row = 4 * r4 + rs;
        const u32x4 v = *(const u32x4*)(proj + (size_t)row * NP + C_BC + 8 * l16);
        float x[8] = {bflo(v.x), bfhi(v.x), bflo(v.y), bfhi(v.y), bflo(v.z), bfhi(v.z), bflo(v.w), bfhi(v.w)};
        float ss = 0.f;
#pragma unroll
        for (int i = 0; i < 8; ++i) ss += x[i] * x[i];
        ss += __shfl_xor(ss, 1); ss += __shfl_xor(ss, 2); ss += __shfl_xor(ss, 4); ss += __shfl_xor(ss, 8);
        const float rr = __builtin_amdgcn_rsqf(ss * (1.f / 128.f) + LN_EPS);
        u32x4 o; o.x = pk2(x[0] * rr * g0[0], x[1] * rr * g0[1]); o.y = pk2(x[2] * rr * g0[2], x[3] * rr * g0[3]);
        o.z = pk2(x[4] * rr * g1[0], x[5] * rr * g1[1]); o.w = pk2(x[6] * rr * g1[2], x[7] * rr * g1[3]);
        *(u32x4*)(ckv + (size_t)row * 128 + 8 * l16) = o;
        if (l16 < 4) *(u32x4*)(ikp + (size_t)row * 32 + 8 * l16) = *(const u32x4*)(proj + (size_t)row * NP + C_IK + 8 * l16);
    }
}

__device__ __forceinline__ float relu_(float x) { const int xi = __float_as_int(x); return __int_as_float(xi > 0 ? xi : 0); }
__device__ __forceinline__ unsigned f2sort(unsigned u) { return u ^ ((unsigned)((int)u >> 31) | 0x80000000u); }
template <bool EXACT>
__device__ __forceinline__ int topk_compact(LAS u32x2* buf, int n, int lane, unsigned& thr_out) {
    unsigned u[8], ky[8];
#pragma unroll
    for (int j = 0; j < 8; ++j) { const int e = j * 64 + lane; u32x2 v = (u32x2){0u, 0u}; if (e < n) v = buf[e]; u[j] = v.x; ky[j] = v.y; }
    unsigned thr = 0u;
    for (int bit = 31; bit >= (EXACT ? 0 : 16); --bit) {
        const unsigned cand = thr | (1u << bit); int c = 0;
#pragma unroll
        for (int j = 0; j < 8; ++j) c += __popcll(__ballot(u[j] >= cand));
        if (c >= 256) thr = cand;
    }
    if (EXACT) {
        int cgt = 0;
#pragma unroll
        for (int j = 0; j < 8; ++j) cgt += __popcll(__ballot(u[j] > thr));
        const int need = 256 - cgt; int pos = 0, eqs = 0;
#pragma unroll
        for (int j = 0; j < 8; ++j) {
            const bool gt = u[j] > thr, eq = u[j] == thr;
            const unsigned long long meq = __ballot(eq);
            const bool keep = gt || (eq && (int)(eqs + mbcnt64(meq)) < need);
            const unsigned long long mk = __ballot(keep);
            if (keep) buf[pos + mbcnt64(mk)] = (u32x2){u[j], ky[j]};
            pos += __popcll(mk); eqs += __popcll(meq);
        }
        thr_out = thr; return 256;
    } else {
        int pos = 0;
#pragma unroll
        for (int j = 0; j < 8; ++j) {
            const bool keep = u[j] >= thr;
            const unsigned long long mk = __ballot(keep);
            if (keep) buf[pos + mbcnt64(mk)] = (u32x2){u[j], ky[j]};
            pos += __popcll(mk);
        }
        thr_out = thr - 1u; return pos;
    }
}
template <int VAR>
__device__ __forceinline__ void topk_phase_t(Frame& F, unsigned* qhead) {
    const bf16_t* proj = (const bf16_t*)(F.ws + WS_PROJ); const float* side = (const float*)(F.ws + WS_SIDE); const bf16_t* ikp = (const bf16_t*)(F.ws + WS_IKP);
    unsigned short* idxo = (unsigned short*)(F.ws + (VAR ? 1010 * MiB : WS_IDX));
    LAS u32x2* wb = (LAS u32x2*)(F.lds + F.wave * 16384);
    const int lane = F.lane, hh = lane >> 5;
    for (;;) {
        int rho = 0;
        if (lane == 0) rho = (int)__hip_atomic_fetch_add(qhead, 1u, __ATOMIC_RELAXED, __HIP_MEMORY_SCOPE_AGENT);
        rho = __builtin_amdgcn_readfirstlane(rho);
        if (rho >= 8192) break;
        const int lb = rho & 3, tg = 2047 - (rho >> 2);
        const int t0 = 4 * tg, rb = lb * SEQ;
        bf16x8 aq0, aq1;
        { const int q = (lane & 31) >> 3, h = lane & 7; const bf16_t* p = proj + (size_t)(rb + t0 + q) * NP + C_IQ + h * 32 + 8 * hh; aq0 = *(const bf16x8*)p; aq1 = *(const bf16x8*)(p + 16); }
        float wq[16];
#pragma unroll
        for (int r = 0; r < 16; ++r) wq[r] = side[(size_t)(rb + t0 + (r >> 2)) * 16 + 8 + (r & 3) + 4 * hh] * 0.0625f;
        unsigned tau_a = 0u, tau_b = 0u; int c0 = 0, c1 = 0, c2 = 0, c3 = 0;
        const int ntile = (t0 + 3) / 32 + 1, npair = (ntile + 1) >> 1;
        const bf16_t* kbase = ikp + (size_t)(rb + (lane & 31)) * 32 + 8 * hh;
        bf16x8 n1[4], n2[4];
#pragma unroll
        for (int i = 0; i < 2; ++i) { const int ja = (i < ntile) ? i : ntile - 1, jb = (2 + i < ntile) ? 2 + i : ntile - 1;
            n1[2 * i] = *(const bf16x8*)(kbase + (size_t)ja * 1024); n1[2 * i + 1] = *(const bf16x8*)(kbase + (size_t)ja * 1024 + 16);
            n2[2 * i] = *(const bf16x8*)(kbase + (size_t)jb * 1024); n2[2 * i + 1] = *(const bf16x8*)(kbase + (size_t)jb * 1024 + 16); }
        for (int jp = 0; jp < npair; ++jp) {
            bf16x8 bb[4];
#pragma unroll
            for (int i = 0; i < 4; ++i) { bb[i] = n1[i]; n1[i] = n2[i]; }
#pragma unroll
            for (int i = 0; i < 2; ++i) { const int jn = (2 * jp + 4 + i < ntile) ? 2 * jp + 4 + i : ntile - 1; n2[2 * i] = *(const bf16x8*)(kbase + (size_t)jn * 1024); n2[2 * i + 1] = *(const bf16x8*)(kbase + (size_t)jn * 1024 + 16); }
            if (c0 > 448) { unsigned t; c0 = topk_compact<false>(wb, c0, lane, t); if (c0 > 416) c0 = topk_compact<true>(wb, c0, lane, t); if (!hh) tau_a = t; }
            if (c1 > 448) { unsigned t; c1 = topk_compact<false>(wb + 512, c1, lane, t); if (c1 > 416) c1 = topk_compact<true>(wb + 512, c1, lane, t); if (!hh) tau_b = t; }
            if (c2 > 448) { unsigned t; c2 = topk_compact<false>(wb + 1024, c2, lane, t); if (c2 > 416) c2 = topk_compact<true>(wb + 1024, c2, lane, t); if (hh) tau_a = t; }
            if (c3 > 448) { unsigned t; c3 = topk_compact<false>(wb + 1536, c3, lane, t); if (c3 > 416) c3 = topk_compact<true>(wb + 1536, c3, lane, t); if (hh) tau_b = t; }
            f32x16 acc[2];
#pragma unroll
            for (int i = 0; i < 2; ++i) {
#pragma unroll
                for (int r = 0; r < 16; ++r) acc[i][r] = 0.f;
                acc[i] = __builtin_amdgcn_mfma_f32_32x32x16_bf16(aq0, bb[2 * i], acc[i], 0, 0, 0);
                acc[i] = __builtin_amdgcn_mfma_f32_32x32x16_bf16(aq1, bb[2 * i + 1], acc[i], 0, 0, 0); }
            unsigned ua[2], ub[2];
#pragma unroll
            for (int i = 0; i < 2; ++i) {
                float p[4];
#pragma unroll
                for (int q = 0; q < 4; ++q) { const float a0 = acc[i][4 * q], a1 = acc[i][4 * q + 1], a2 = acc[i][4 * q + 2], a3 = acc[i][4 * q + 3]; p[q] = (relu_(a0) * wq[4 * q] + relu_(a1) * wq[4 * q + 1]) + (relu_(a2) * wq[4 * q + 2] + relu_(a3) * wq[4 * q + 3]); }
                auto r02 = __builtin_amdgcn_permlane32_swap(__float_as_uint(p[0]), __float_as_uint(p[2]), false, false);
                auto r13 = __builtin_amdgcn_permlane32_swap(__float_as_uint(p[1]), __float_as_uint(p[3]), false, false);
                const unsigned r02a = r02[0], r02b = r02[1], r13a = r13[0], r13b = r13[1];
                ua[i] = f2sort(__float_as_uint(__uint_as_float(r02a) + __uint_as_float(r02b)));
                ub[i] = f2sort(__float_as_uint(__uint_as_float(r13a) + __uint_as_float(r13b)));
            }
#pragma unroll
            for (int i = 0; i < 2; ++i) {
                const int key = 32 * (2 * jp + i) + (lane & 31);
                {
                    const bool pa = (VAR == 3) ? false : (key <= t0 + 2 * hh) && (ua[i] > tau_a) && (VAR != 2 || (hh ? c2 : c0) < 440);
                    const unsigned long long m = __ballot(pa); const unsigned mlo = (unsigned)m, mhi = (unsigned)(m >> 32);
                    const unsigned off = hh ? __builtin_amdgcn_mbcnt_hi(mhi, 0u) : __builtin_amdgcn_mbcnt_lo(mlo, 0u);
                    if (pa) wb[(hh ? 1024 + c2 : c0) + off] = (u32x2){ua[i], (unsigned)key};
                    c0 += __popc(mlo); c2 += __popc(mhi);
                }
                {
                    const bool pb = (VAR == 3) ? false : (key <= t0 + 1 + 2 * hh) && (ub[i] > tau_b) && (VAR != 2 || (hh ? c3 : c1) < 440);
                    const unsigned long long m = __ballot(pb); const unsigned mlo = (unsigned)m, mhi = (unsigned)(m >> 32);
                    const unsigned off = hh ? __builtin_amdgcn_mbcnt_hi(mhi, 0u) : __builtin_amdgcn_mbcnt_lo(mlo, 0u);
                    if (pb) wb[(hh ? 1536 + c3 : 512 + c1) + off] = (u32x2){ub[i], (unsigned)key};
                    c1 += __popc(mlo); c3 += __popc(mhi);
                }
            }
        }
        { unsigned t;
          if (c0 > 256) c0 = topk_compact<true>(wb, c0, lane, t);
          if (c1 > 256) c1 = topk_compact<true>(wb + 512, c1, lane, t);
          if (c2 > 256) c2 = topk_compact<true>(wb + 1024, c2, lane, t);
          if (c3 > 256) c3 = topk_compact<true>(wb + 1536, c3, lane, t); }
#pragma unroll
        for (int q = 0; q < 4; ++q) {
            const int n = (q == 0) ? c0 : (q == 1) ? c1 : (q == 2) ? c2 : c3;
            unsigned k4[4];
#pragma unroll
            for (int i = 0; i < 4; ++i) { const int pz = 4 * lane + i; k4[i] = (pz < n) ? wb[q * 512 + pz].y : 0u; }
            *(u32x2*)(idxo + (size_t)(rb + t0 + q) * 256 + 4 * lane) = (u32x2){k4[0] | (k4[1] << 16), k4[2] | (k4[3] << 16)};
        }
    }
}

__device__ __forceinline__ void topk_phase(Frame& F, unsigned* qhead) { topk_phase_t<0>(F, qhead); }

__device__ __forceinline__ unsigned offb(unsigned row, unsigned ch) { return 256u * row + 16u * (ch ^ (((row & 3u) << 2) | ((row >> 2) & 3u))); }
__device__ __forceinline__ bf16x8 tr_read2(unsigned a0, unsigned a1) {
    u32x2 r0, r1;
    asm volatile("ds_read_b64_tr_b16 %0, %2\n\tds_read_b64_tr_b16 %1, %3\n\ts_waitcnt lgkmcnt(0)" : "=&v"(r0), "=&v"(r1) : "v"(a0), "v"(a1) : "memory");
    const u32x4 v = (u32x4){r0.x, r0.y, r1.x, r1.y};
    return __builtin_bit_cast(bf16x8, v);
}
__device__ __forceinline__ float xrow_max(float x) {
    auto s = __builtin_amdgcn_permlane16_swap(__float_as_uint(x), __float_as_uint(x), false, false); const unsigned s0 = s[0], s1 = s[1];
    x = fmaxf(__uint_as_float(s0), __uint_as_float(s1));
    auto t = __builtin_amdgcn_permlane32_swap(__float_as_uint(x), __float_as_uint(x), false, false); const unsigned t0 = t[0], t1 = t[1];
    return fmaxf(__uint_as_float(t0), __uint_as_float(t1));
}
__device__ __forceinline__ float xrow_sum(float x) {
    auto s = __builtin_amdgcn_permlane16_swap(__float_as_uint(x), __float_as_uint(x), false, false); const unsigned s0 = s[0], s1 = s[1];
    x = __uint_as_float(s0) + __uint_as_float(s1);
    auto t = __builtin_amdgcn_permlane32_swap(__float_as_uint(x), __float_as_uint(x), false, false); const unsigned t0 = t[0], t1 = t[1];
    return __uint_as_float(t0) + __uint_as_float(t1);
}
__device__ __forceinline__ void tr_read8(const unsigned (&a)[8], bf16x8 (&o)[4]) {
    u32x2 r0, r1, r2, r3, r4, r5, r6, r7;
    asm volatile("ds_read_b64_tr_b16 %0, %8\n\tds_read_b64_tr_b16 %1, %9\n\tds_read_b64_tr_b16 %2, %10\n\tds_read_b64_tr_b16 %3, %11\n\t"
                 "ds_read_b64_tr_b16 %4, %12\n\tds_read_b64_tr_b16 %5, %13\n\tds_read_b64_tr_b16 %6, %14\n\tds_read_b64_tr_b16 %7, %15\n\ts_waitcnt lgkmcnt(0)"
                 : "=&v"(r0), "=&v"(r1), "=&v"(r2), "=&v"(r3), "=&v"(r4), "=&v"(r5), "=&v"(r6), "=&v"(r7)
                 : "v"(a[0]), "v"(a[1]), "v"(a[2]), "v"(a[3]), "v"(a[4]), "v"(a[5]), "v"(a[6]), "v"(a[7]) : "memory");
    o[0] = __builtin_bit_cast(bf16x8, (u32x4){r0.x, r0.y, r1.x, r1.y}); o[1] = __builtin_bit_cast(bf16x8, (u32x4){r2.x, r2.y, r3.x, r3.y});
    o[2] = __builtin_bit_cast(bf16x8, (u32x4){r4.x, r4.y, r5.x, r5.y}); o[3] = __builtin_bit_cast(bf16x8, (u32x4){r6.x, r6.y, r7.x, r7.y});
}
template <int VAR>
__device__ __forceinline__ void attn_phase_t(Frame& F) {
    bf16_t* proj = (bf16_t*)(F.ws + WS_PROJ); const bf16_t* ckv = (const bf16_t*)(F.ws + WS_CKV); const unsigned short* idxg = (const unsigned short*)(F.ws + WS_IDX);
    const float* relb = F.ap->in[I_RELB];
    LAS float* biasl = (LAS float*)(F.lds + LDS_AUX);
    LAS unsigned short* idxs = (LAS unsigned short*)(F.lds + LDS_AUX + 4608 + F.wave * 512);
    LAS unsigned char* tile = F.lds + F.wave * 16384;
    const unsigned tile_addr = (unsigned)(uintptr_t)tile;
    for (int i = F.tid; i < 129 * 8; i += 512) { const int d = i >> 3, h = i & 7; int bk = d;
        if (d >= 16) { bk = 16 + (int)(logf((float)d * (1.f / 16.f)) / logf(8.f) * 16.f); if (bk > 31) bk = 31; }
        biasl[i] = relb[bk * 8 + h]; }
    __syncthreads();
    const int lane = F.lane, g4 = lane >> 4, c15 = lane & 15, qq = c15 >> 2, pp = lane & 3;
    const bool hv = c15 < 8;
    LAS unsigned short* idxb = (LAS unsigned short*)(F.lds + LDS_AUX + 4608 + F.wave * 1024);
    u32x4 nx[4][4]; bf16x8 bq[4];
    {
        const int r = F.gw; const int lb = r >> 13;
        *(LAS u32x2*)(idxb + 4 * lane) = *(const u32x2*)(idxg + (size_t)r * 256 + 4 * lane);
#pragma unroll
        for (int ks = 0; ks < 4; ++ks) { u32x4 v = (u32x4){0u, 0u, 0u, 0u}; if (hv) v = *(const u32x4*)(proj + (size_t)r * NP + C_QL + c15 * 128 + 32 * ks + 8 * g4); bq[ks] = __builtin_bit_cast(bf16x8, v); }
        LDS_WAIT();
        const bf16_t* cbase = ckv + (size_t)lb * SEQ * 128 + 8 * g4;
#pragma unroll
        for (int grp = 0; grp < 4; ++grp) { const int key = idxb[16 * grp + c15]; const bf16_t* kr = cbase + (size_t)key * 128;
#pragma unroll
            for (int ks = 0; ks < 4; ++ks) nx[grp][ks] = *(const u32x4*)(kr + 32 * ks); }
    }
    int it = 0;
    for (int r = F.gw; r < MH; r += F.NGW, ++it) {
        const int t = r & (SEQ - 1), lb = r >> 13;
        const int nsel = (t + 1 < 256) ? t + 1 : 256;
        LAS unsigned short* idxs = idxb + (it & 1) * 256; LAS unsigned short* idxn = idxb + ((it & 1) ^ 1) * 256;
        const int rn = r + F.NGW; const bool have_next = rn < MH;
        u32x2 idn = (u32x2){0u, 0u}; bf16x8 bqn[4];
        if (have_next) { idn = *(const u32x2*)(idxg + (size_t)rn * 256 + 4 * lane);
#pragma unroll
            for (int ks = 0; ks < 4; ++ks) { u32x4 v = (u32x4){0u, 0u, 0u, 0u}; if (hv) v = *(const u32x4*)(proj + (size_t)rn * NP + C_QL + c15 * 128 + 32 * ks + 8 * g4); bqn[ks] = __builtin_bit_cast(bf16x8, v); } }
        else {
#pragma unroll
            for (int ks = 0; ks < 4; ++ks) bqn[ks] = bq[ks]; }
        float mrun = -1e30f, lsum = 0.f;
        f32x4 O[8];
#pragma unroll
        for (int c = 0; c < 8; ++c) O[c] = (f32x4){0.f, 0.f, 0.f, 0.f};
        const int nch = (nsel + 63) >> 6;
        const bf16_t* cbase = ckv + (size_t)lb * SEQ * 128 + 8 * g4;
        for (int cch = 0; cch < nch; ++cch) {
            float bs[4][4];
#pragma unroll
            for (int grp = 0; grp < 4; ++grp) {
                const u32x2 k4 = *(const LAS u32x2*)(idxs + 64 * cch + 16 * grp + 4 * g4);
                const int kk[4] = {(int)(k4.x & 0xffffu), (int)(k4.x >> 16), (int)(k4.y & 0xffffu), (int)(k4.y >> 16)};
#pragma unroll
                for (int j = 0; j < 4; ++j) { const int pz = 64 * cch + 16 * grp + 4 * g4 + j; int d = t - kk[j]; d = d < 0 ? 0 : (d > 128 ? 128 : d);
                    const float bv = biasl[d * 8 + (c15 & 7)]; bs[grp][j] = (pz < nsel) ? bv : -1e30f; }
            }
            f32x4 L[4];
#pragma unroll
            for (int grp = 0; grp < 4; ++grp) {
                f32x4 a = (f32x4){0.f, 0.f, 0.f, 0.f};
#pragma unroll
                for (int ks = 0; ks < 4; ++ks) { *(LAS u32x4*)(tile + offb(16 * grp + c15, 4 * ks + g4)) = nx[grp][ks]; a = __builtin_amdgcn_mfma_f32_16x16x32_bf16(__builtin_bit_cast(bf16x8, nx[grp][ks]), bq[ks], a, 0, 0, 0); }
                L[grp] = a;
            }
            if (VAR == 4 && cch + 1 < nch) { } else if (cch + 1 < nch) {
#pragma unroll
                for (int grp = 0; grp < 4; ++grp) { const int key = idxs[64 * (cch + 1) + 16 * grp + c15]; const bf16_t* kr = cbase + (size_t)key * 128;
#pragma unroll
                    for (int ks = 0; ks < 4; ++ks) nx[grp][ks] = *(const u32x4*)(kr + 32 * ks); }
            } else if (have_next) {
                *(LAS u32x2*)(idxn + 4 * lane) = idn; LDS_WAIT();
                const bf16_t* cbn = ckv + (size_t)(rn >> 13) * SEQ * 128 + 8 * g4;
#pragma unroll
                for (int grp = 0; grp < 4; ++grp) { const int key = idxn[16 * grp + c15]; const bf16_t* kr = cbn + (size_t)key * 128;
#pragma unroll
                    for (int ks = 0; ks < 4; ++ks) if (VAR != 4) nx[grp][ks] = *(const u32x4*)(kr + 32 * ks); }
            }
            float cmax = -1e30f;
#pragma unroll
            for (int grp = 0; grp < 4; ++grp)
#pragma unroll
                for (int j = 0; j < 4; ++j) { float lg = L[grp][j] * 0.125f + bs[grp][j]; lg = (bs[grp][j] > -1e29f) ? lg : -1e30f; L[grp][j] = lg; cmax = fmaxf(cmax, lg); }
            cmax = xrow_max(cmax);
            const float mnew = fmaxf(mrun, cmax), alpha = __expf(mrun - mnew);
            float ps = 0.f;
#pragma unroll
            for (int grp = 0; grp < 4; ++grp)
#pragma unroll
                for (int j = 0; j < 4; ++j) { float pv = __expf(L[grp][j] - mnew); pv = (hv && L[grp][j] > -1e29f) ? pv : 0.f; L[grp][j] = pv; ps += pv; }
            lsum = lsum * alpha + ps; mrun = mnew;
            bf16x8 pa[2];
#pragma unroll
            for (int kk2 = 0; kk2 < 2; ++kk2) { const u32x4 v = (u32x4){cvt_pk_bf16(L[2 * kk2][0], L[2 * kk2][1]), cvt_pk_bf16(L[2 * kk2][2], L[2 * kk2][3]), cvt_pk_bf16(L[2 * kk2 + 1][0], L[2 * kk2 + 1][1]), cvt_pk_bf16(L[2 * kk2 + 1][2], L[2 * kk2 + 1][3])}; pa[kk2] = __builtin_bit_cast(bf16x8, v); }
            float ar[4];
#pragma unroll
            for (int j = 0; j < 4; ++j) { const float lo = __uint_as_float(__builtin_amdgcn_readlane(__float_as_uint(alpha), j)), hi = __uint_as_float(__builtin_amdgcn_readlane(__float_as_uint(alpha), 4 + j)); ar[j] = (g4 & 1) ? hi : lo; }
#pragma unroll
            for (int c = 0; c < 8; ++c)
#pragma unroll
                for (int j = 0; j < 4; ++j) O[c][j] *= ar[j];
            LDS_WAIT();
#pragma unroll
            for (int kk2 = 0; kk2 < 2; ++kk2) {
                unsigned ad0[8], ad1[8]; bf16x8 bv0[4], bv1[4];
#pragma unroll
                for (int i = 0; i < 4; ++i) { ad0[2 * i] = tile_addr + offb(32 * kk2 + 4 * g4 + qq, 2 * i + (pp >> 1)) + 8 * (pp & 1); ad0[2 * i + 1] = tile_addr + offb(32 * kk2 + 16 + 4 * g4 + qq, 2 * i + (pp >> 1)) + 8 * (pp & 1);
                    ad1[2 * i] = tile_addr + offb(32 * kk2 + 4 * g4 + qq, 2 * (4 + i) + (pp >> 1)) + 8 * (pp & 1); ad1[2 * i + 1] = tile_addr + offb(32 * kk2 + 16 + 4 * g4 + qq, 2 * (4 + i) + (pp >> 1)) + 8 * (pp & 1); }
                if (VAR != 2) { tr_read8(ad0, bv0); tr_read8(ad1, bv1); } else { for (int i = 0; i < 4; ++i) { bv0[i] = pa[kk2]; bv1[i] = pa[kk2]; } }
#pragma unroll
                for (int i = 0; i < 4; ++i) { O[i] = __builtin_amdgcn_mfma_f32_16x16x32_bf16(pa[kk2], bv0[i], O[i], 0, 0, 0); O[4 + i] = __builtin_amdgcn_mfma_f32_16x16x32_bf16(pa[kk2], bv1[i], O[4 + i], 0, 0, 0); }
            }
        }
        lsum = xrow_sum(lsum);
        const float inv = __builtin_amdgcn_rcpf(lsum);
        float ir[4];
#pragma unroll
        for (int j = 0; j < 4; ++j) { const float lo = __uint_as_float(__builtin_amdgcn_readlane(__float_as_uint(inv), j)), hi = __uint_as_float(__builtin_amdgcn_readlane(__float_as_uint(inv), 4 + j)); ir[j] = (g4 & 1) ? hi : lo; }
        LAS bf16_t* ost = (LAS bf16_t*)tile;
        if (g4 < 2) {
#pragma unroll
            for (int c = 0; c < 8; ++c)
#pragma unroll
                for (int j = 0; j < 4; ++j) ost[(4 * g4 + j) * 128 + 16 * c + c15] = (bf16_t)f2bf(EXP_ZERO_DSA ? 0.f : O[c][j] * ir[j]);
        }
        LDS_WAIT();
        {
            bf16_t* dst = VAR ? (bf16_t*)(F.ws + 1010 * MiB) + (size_t)(r & 4095) * 1024 : (bf16_t*)(F.ws + WS_OL) + (size_t)r * 1024;
            const u32x4 o0 = *(const LAS u32x4*)(ost + 8 * lane), o1 = *(const LAS u32x4*)(ost + 512 + 8 * lane);
            *(u32x4*)(dst + 8 * lane) = o0; *(u32x4*)(dst + 512 + 8 * lane) = o1;
        }
        LDS_WAIT();
#pragma unroll
        for (int ks = 0; ks < 4; ++ks) bq[ks] = bqn[ks];
    }
}
__device__ __forceinline__ void attn_phase(Frame& F) { attn_phase_t<0>(F); }
__device__ __forceinline__ void prologue(Frame& F) {
    int base = 0;
    for (int l = 0; l < DEPTH; ++l) {
        unsigned char* wm = F.ws + WS_WMIX + (size_t)l * WMIX_LAYER;
        { ValInProj v{F.ap->in[I_WIN] + (size_t)l * D * DIN, F.ap->in[I_WUK] + (size_t)l * 8 * 64 * 128}; convert_matrix(F, v, D, NP, (bf16_t*)(wm + WM_IN), base); }
        { ValPlain v{F.ap->in[I_WBA] + (size_t)l * 512 * D, D}; convert_matrix(F, v, 512, D, (bf16_t*)(wm + WM_A), base); }
        { ValOB v{F.ap->in[I_WUV] + (size_t)l * 8 * 128 * 64, F.ap->in[I_WBB] + (size_t)l * 512 * D}; convert_matrix(F, v, D, D, (bf16_t*)(wm + WM_OB), base); }
        { ValPlain v{F.ap->in[I_WOUT] + (size_t)l * D * D, D}; convert_matrix(F, v, D, D, (bf16_t*)(wm + WM_OUT), base); }
    }
    bf16_t* xb = (bf16_t*)(F.ws + WS_XB);
    for (int r = F.gw; r < BATCH * SEQ; r += F.NGW) {
        const float* xr = F.ap->in[I_X] + (size_t)r * D + 4 * F.lane;
#pragma unroll
        for (int j = 0; j < 4; ++j) { const f32x4 v = *(const f32x4*)(xr + 256 * j);
            u32x2 w; w.x = cvt_pk_bf16(v[0], v[1]); w.y = cvt_pk_bf16(v[2], v[3]); *(u32x2*)(xb + (size_t)r * D + 4 * F.lane + 256 * j) = w; }
    }
}
__device__ __forceinline__ void ffn_weights(Frame& F, int l) {
    int base = 0; const int j = l >> 1;
    if ((l & 1) == 0) {
        { ValGU v{F.ap->in[I_DWG] + (size_t)j * D * DFF, F.ap->in[I_DWU] + (size_t)j * D * DFF, DFF}; convert_matrix64(F, v, D, 2 * DFF, (bf16_t*)(F.ws + WS_WFFN), base); }
        { ValPlain v{F.ap->in[I_DWD] + (size_t)j * DFF * D, D}; convert_matrix64(F, v, DFF, D, (bf16_t*)(F.ws + WS_WFFN + WF_D_OFF), base); }
    } else {
        for (int e = 0; e < NEXP; ++e) {
            { ValGU v{F.ap->in[I_EWG] + (size_t)(j * NEXP + e) * D * DFE, F.ap->in[I_EWU] + (size_t)(j * NEXP + e) * D * DFE, DFE}; convert_matrix64(F, v, D, 2 * DFE, (bf16_t*)(F.ws + WS_WFFN + (size_t)e * WF_GU_E), base); }
            { ValPlain v{F.ap->in[I_EWD] + (size_t)(j * NEXP + e) * DFE * D, D}; convert_matrix64(F, v, DFE, D, (bf16_t*)(F.ws + WS_WFFN + WF_D_OFF + (size_t)e * WF_D_E), base); }
        }
    }
}

enum { K_PRO = 0, K_FW, K_A, K_B, K_C, K_D, K_E, K_F, K_G, K_H1, K_H2, K_H3, K_H4, K_N };
template <int KIND>
__device__ __forceinline__ void run_phase(Frame& F0, int l, int hf) {
    Frame F = F0;
    { int t = F0.tid; asm volatile("" : "+v"(t)); F.tid = t; F.lane = t & 63; F.wave = __builtin_amdgcn_readfirstlane(t >> 6); }
    int cb = blockIdx.x; asm volatile("" : "+s"(cb)); asm volatile("" : "+s"(l)); asm volatile("" : "+s"(hf));
    { CArgs a = F0.ap; asm volatile("" : "+s"(a)); F.ap = a; F.ws = a->ws; F.out = a->out; }
    F.vcu = cb; F.gw = cb * 8 + F.wave;
    LAS unsigned char* L = F.lds;
    const int G = F.G;
    bf16_t* proj = (bf16_t*)(F.ws + WS_PROJ);
    const unsigned char* wm = F.ws + WS_WMIX + (size_t)l * WMIX_LAYER;
    const bool whole = (hf == 2);
    const int mrows = whole ? 2 * MH : MH;
    const bf16_t* xbh = (const bf16_t*)(F.ws + WS_XB) + (size_t)(whole ? 0 : hf) * MH * D;
    float* outh = F.out + (size_t)(whole ? 0 : hf) * MH * D;
    const bool moe = (l & 1) != 0;
    const unsigned* meta = (const unsigned*)(F.ws + WS_MISC + MS_META);
    if constexpr (KIND == K_PRO) prologue(F);
    if constexpr (KIND == K_FW) { }
    if constexpr (KIND == K_A) { pg8::Gemm g{xbh, (const bf16_t*)(wm + WM_IN), D, D, D}; pg8::Order S; S.init(MH / 256, NP / 256, G, cb, g, nullptr, 0, WGM_A);
        pg8::EpiInProj E{proj, (float*)(F.ws + WS_SIDE), (bf16_t*)(F.ws + WS_MG), (bf16_t*)(F.ws + WS_GB)}; pg8::gemm_phase(L, g, S, E, F.tid); }
    if constexpr (KIND == K_B) { mlstm_local(F, l); ckv_pass(F, l); if (hf == 0) ffn_weights(F, l); }
    if constexpr (KIND == K_C) {
#if defined(TIME_SUB) && TIME_SUB >= 3 && TIME_SUB <= 5
        topk_phase(F, (unsigned*)(F.ws + WS_CTL) + 8192 + 64 * (2 * l + hf));
        __syncthreads(); const unsigned long long ta_ = __builtin_amdgcn_s_memrealtime();
        mlstm_scan(F);
        __syncthreads(); const unsigned long long tb_ = __builtin_amdgcn_s_memrealtime();
        if (F.tid == 0) { volatile LAS unsigned long long* tacc = (volatile LAS unsigned long long*)(F.lds + LDS_CTLW + 128); tacc[0] += (tb_ - ta_); }
#elif defined(TIME_SUB) && TIME_SUB >= 11 && TIME_SUB <= 13
        topk_phase(F, (unsigned*)(F.ws + WS_CTL) + 8192 + 64 * (2 * l + hf)); __syncthreads(); mlstm_scan(F);
        __syncthreads(); const unsigned long long ta_ = __builtin_amdgcn_s_memrealtime();
        topk_phase_t<TIME_SUB - 10>(F, (unsigned*)(F.ws + WS_CTL) + 16384 + 64 * (2 * l + hf));
        __syncthreads(); const unsigned long long tb_ = __builtin_amdgcn_s_memrealtime();
        if (F.tid == 0) { volatile LAS unsigned long long* tacc = (volatile LAS unsigned long long*)(F.lds + LDS_CTLW + 128); tacc[0] += (tb_ - ta_); }
#elif defined(TIME_SUB) && TIME_SUB == 6
        mlstm_scan(F); __syncthreads(); topk_phase(F, (unsigned*)(F.ws + WS_CTL) + 8192 + 64 * (2 * l + hf));
        for (int rep = 0; rep < 2; ++rep) {
            __syncthreads(); const unsigned long long ta_ = __builtin_amdgcn_s_memrealtime();
            mlstm_scan_t<true>(F);
            __syncthreads(); const unsigned long long tb_ = __builtin_amdgcn_s_memrealtime();
            if (F.tid == 0 && rep == TIME_REP) { volatile LAS unsigned long long* tacc = (volatile LAS unsigned long long*)(F.lds + LDS_CTLW + 128); tacc[0] += (tb_ - ta_); }
        }
#else
        topk_phase(F, (unsigned*)(F.ws + WS_CTL) + 8192 + 64 * (2 * l + hf)); __syncthreads(); mlstm_scan(F);
#endif
    }
    if constexpr (KIND == K_D) {
#if defined(TIME_SUB) && TIME_SUB && TIME_SUB <= 2
        const unsigned long long ta_ = __builtin_amdgcn_s_memrealtime();
        mlstm_out(F, l);
        __syncthreads(); const unsigned long long tb_ = __builtin_amdgcn_s_memrealtime();
        attn_phase(F);
        __syncthreads(); const unsigned long long tc_ = __builtin_amdgcn_s_memrealtime();
        if (F.tid == 0) { volatile LAS unsigned long long* tacc = (volatile LAS unsigned long long*)(F.lds + LDS_CTLW + 128); tacc[0] += (TIME_SUB == 1) ? (tb_ - ta_) : (tc_ - tb_); }
#elif defined(TIME_SUB) && TIME_SUB >= 7
        mlstm_out(F, l); attn_phase(F);
        __syncthreads(); const unsigned long long ta_ = __builtin_amdgcn_s_memrealtime();
        attn_phase_t<TIME_SUB - 6>(F);
        __syncthreads(); const unsigned long long tb_ = __builtin_amdgcn_s_memrealtime();
        if (F.tid == 0) { volatile LAS unsigned long long* tacc = (volatile LAS unsigned long long*)(F.lds + LDS_CTLW + 128); tacc[0] += (tb_ - ta_); }
#else
        mlstm_out(F, l); attn_phase(F);
#endif
    }
    if constexpr (KIND == K_E) {
        { pg8::Gemm g{(const bf16_t*)(F.ws + WS_YA), (const bf16_t*)(wm + WM_A), 512, 512, 512}; pg8::Order S; S.init(MH / 256, D / 256, G, cb, g); pg8::EpiMerge<0> E{(bf16_t*)(F.ws + WS_MG), (const bf16_t*)(F.ws + WS_GB)}; pg8::gemm_phase(L, g, S, E, F.tid); }
        { pg8::Gemm g{(const bf16_t*)(F.ws + WS_OL), (const bf16_t*)(wm + WM_OB), D, D, D}; pg8::Order S; S.init(MH / 256, D / 256, G, cb, g); pg8::EpiMerge<1> E{(bf16_t*)(F.ws + WS_MG), (const bf16_t*)(F.ws + WS_GB)}; pg8::gemm_phase(L, g, S, E, F.tid); }
    }
    if constexpr (KIND == K_F) { pg8::Gemm g{(const bf16_t*)(F.ws + WS_MG), (const bf16_t*)(wm + WM_OUT), D, D, D}; pg8::Order S; S.init(MH / 256, D / 256, G, cb, g); pg8::EpiResid E{xbh, (bf16_t*)(F.ws + WS_PRE)}; pg8::gemm_phase(L, g, S, E, F.tid); }
    if constexpr (KIND == K_G) { if (moe) ln_pass<0, true>(F, l, 0, hf, nullptr, nullptr); else ln_pass<0, false>(F, l, 0, hf, nullptr, nullptr); }
    if constexpr (KIND == K_H1) { if (moe) moe_scatter(F, hf); }
    if constexpr (KIND == K_H2) {
        const int nblk = moe ? (int)meta[0] : mrows / 256;
        pg8::Gemm g{moe ? (const bf16_t*)(F.ws + WS_XS) : xbh, (const bf16_t*)(F.ws + WS_WFFN), D, D, D}; pg8::Order S;
        S.init(nblk, moe ? (2 * DFE) / 256 : (2 * DFF) / 256, G, cb, g, moe ? meta + 16 : nullptr, WF_GU_E, WGM_F);
        pg8::EpiSwiglu E{moe ? (bf16_t*)(F.ws + WS_HM) : (bf16_t*)(F.ws + WS_HD), moe ? DFE : DFF}; pg8::gemm_phase(L, g, S, E, F.tid);
    }
    if constexpr (KIND == K_H3) {
        if (moe) { const int nblk = (int)meta[0]; pg8::Gemm g{(const bf16_t*)(F.ws + WS_HM), (const bf16_t*)(F.ws + WS_WFFN + WF_D_OFF), DFE, DFE, DFE}; pg8::Order S;
            S.init(nblk, D / 256, G, cb, g, meta + 16, WF_D_E, WGM_F); pg8::EpiMoeDown E{(bf16_t*)(F.ws + WS_XS), (const float*)(F.ws + WS_MISC + MS_RG)}; pg8::gemm_phase(L, g, S, E, F.tid); }
        else { pg8::Gemm g{(const bf16_t*)(F.ws + WS_HD), (const bf16_t*)(F.ws + WS_WFFN + WF_D_OFF), DFF, DFF, DFF}; pg8::Order S; S.init(mrows / 256, D / 256, G, cb, g, nullptr, 0, WGM_F);
            pg8::EpiResid E{xbh, (bf16_t*)(F.ws + (whole ? WS_PRE2 : WS_PRE))}; pg8::gemm_phase(L, g, S, E, F.tid); }
    }
    if constexpr (KIND == K_H4) { if (moe) ln_pass<1, false>(F, l, 1, hf, (const bf16_t*)(F.ws + WS_XS), (const unsigned*)(F.ws + WS_MISC + MS_TD)); else ln_pass<0, false>(F, l, 1, hf, nullptr, nullptr); }
}
__device__ __forceinline__ void frame_init(Frame& F, const Args& args, unsigned char* lds_raw) {
    F.lds = (LAS unsigned char*)lds_raw;
    F.tid = threadIdx.x; F.lane = F.tid & 63; F.wave = __builtin_amdgcn_readfirstlane(F.tid >> 6);
    F.G = gridDim.x; F.vcu = blockIdx.x; F.gw = blockIdx.x * 8 + F.wave; F.NGW = F.G * 8;
    F.ap = (CArgs)__builtin_amdgcn_kernarg_segment_ptr(); F.out = F.ap->out; F.ws = F.ap->ws;
}
template <int KIND> __global__ void __launch_bounds__(512, 2) k_one(Args args) {
    extern __shared__ __attribute__((aligned(16))) unsigned char lds_raw[];
    Frame F; frame_init(F, args, lds_raw);
    run_phase<KIND>(F, args.ph_lo, args.ph_hi);
}
#if MK_ONE_LAUNCH
#ifndef TIME_SEL
#define TIME_SEL 0
#endif
#if TIME_SEL
#define PH(KIND, L, HF, BAR) do { const unsigned long long t0_ = __builtin_amdgcn_s_memrealtime(); run_phase<KIND>(F, L, HF); asm volatile("s_waitcnt vmcnt(0)" ::: "memory"); __syncthreads(); const unsigned long long t1_ = __builtin_amdgcn_s_memrealtime(); \
    if (BAR) xcd_barrier(bar); const unsigned long long t2_ = __builtin_amdgcn_s_memrealtime(); if (F.tid == 0) { if ((TIME_SEL >> KIND) & 1) tacc[0] += t1_ - t0_; if ((TIME_SEL >> 15) & 1) tacc[0] += t2_ - t1_; } } while (0)
#else
#define PH(KIND, L, HF, BAR) do { run_phase<KIND>(F, L, HF); if (BAR) xcd_barrier(bar); } while (0)
#endif
template <int L, int HF> __device__ __forceinline__ void half_program(Frame& F, const XcdBarrier& bar, volatile LAS unsigned long long* tacc) {
    PH(K_A, L, HF, true); PH(K_B, L, HF, true); PH(K_C, L, HF, true); PH(K_D, L, HF, true); PH(K_E, L, HF, true); PH(K_F, L, HF, true); PH(K_G, L, HF, true);
    if constexpr ((L & 1) != 0) { PH(K_H1, L, HF, true); }
    if constexpr ((L & 1) != 0) {
        PH(K_H2, L, HF, true); PH(K_H3, L, HF, true);
        PH(K_H4, L, HF, !(L == DEPTH - 1 && HF == NHALF - 1));
    }
}
template <int L> __device__ __forceinline__ void layer_program(Frame& F, const XcdBarrier& bar, volatile LAS unsigned long long* tacc) {
#if defined(HF_LOOP) && HF_LOOP
    for (int hf = 0; hf < NHALF; ++hf) {
        PH(K_A, L, hf, true); PH(K_B, L, hf, true); PH(K_C, L, hf, true); PH(K_D, L, hf, true); PH(K_E, L, hf, true); PH(K_F, L, hf, true); PH(K_G, L, hf, true);
        if constexpr ((L & 1) != 0) { PH(K_H1, L, hf, true); }
        PH(K_H2, L, hf, true); PH(K_H3, L, hf, true);
        PH(K_H4, L, hf, !(L == DEPTH - 1) || hf == 0);
    }
#else
    half_program<L, 0>(F, bar, tacc);
    half_program<L, 1>(F, bar, tacc);
    if constexpr ((L & 1) == 0) { PH(K_H2, L, 2, true); PH(K_H3, L, 2, true); PH(K_H4, L, 2, true); }
#endif
}
__global__ void __launch_bounds__(512, 2) fwd(Args args) {
    extern __shared__ __attribute__((aligned(16))) unsigned char lds_raw[];
    Frame F; frame_init(F, args, lds_raw);
    volatile LAS unsigned* ctlw = (volatile LAS unsigned*)(F.lds + LDS_CTLW);
    volatile LAS unsigned long long* tacc = (volatile LAS unsigned long long*)(F.lds + LDS_CTLW + 128);
    if (F.tid < 64) ctlw[F.tid] = 0u;
    __syncthreads();
    XcdBarrier bar = xcd_barrier_post((unsigned*)(F.ws + WS_CTL) + CW_BAR, ctlw + 8);
    PH(K_PRO, 0, 0, true);
    layer_program<0>(F, bar, tacc); layer_program<1>(F, bar, tacc); layer_program<2>(F, bar, tacc); layer_program<3>(F, bar, tacc);
#if TIME_SEL || (defined(TIME_SUB) && TIME_SUB)
    if (F.tid == 0) { const unsigned long long d = tacc[0], t0 = __builtin_amdgcn_s_memrealtime(); while (__builtin_amdgcn_s_memrealtime() - t0 < d) __builtin_amdgcn_s_sleep(8); }
#endif
}
#undef PH
#endif

template <int KIND> static void launch_one(int grid, hipStream_t stream, Args a, int l, int hf) {
    static bool attr = false;
    if (!attr) { (void)hipFuncSetAttribute((const void*)k_one<KIND>, hipFuncAttributeMaxDynamicSharedMemorySize, LDS_BYTES); attr = true; }
    a.ph_lo = l; a.ph_hi = hf;
    hipLaunchKernelGGL(k_one<KIND>, dim3(grid), dim3(512), LDS_BYTES, stream, a);
}
extern "C" void kernel_launch(void* const* d_in, const int* in_sizes, int n_in, void* d_out, int out_size, void* d_ws, size_t ws_size, hipStream_t stream) {
    static int grid = 0;
    if (grid == 0) {
        if (n_in != 21 || out_size != BATCH * SEQ * D || ws_size < WS_END) { fprintf(stderr, "kernel_launch: unexpected problem shape (n_in %d, out %d, ws %zu)\n", n_in, out_size, ws_size); grid = -1; return; }
        int dev = 0, cus = 0;
        if (hipGetDevice(&dev) != hipSuccess || hipDeviceGetAttribute(&cus, hipDeviceAttributeMultiprocessorCount, dev) != hipSuccess) { grid = -1; return; }
#if MK_ONE_LAUNCH
        int per_cu = 0;
        if (hipFuncSetAttribute((const void*)fwd, hipFuncAttributeMaxDynamicSharedMemorySize, LDS_BYTES) != hipSuccess) { fprintf(stderr, "kernel_launch: hipFuncSetAttribute failed\n"); grid = -1; return; }
        if (hipOccupancyMaxActiveBlocksPerMultiprocessor(&per_cu, (const void*)fwd, 512, LDS_BYTES) != hipSuccess || per_cu < 1) fprintf(stderr, "kernel_launch: occupancy query reports %d\n", per_cu);
        (void)hipGetLastError();
#endif
        grid = cus;
    }
    if (grid < 0) return;
    (void)in_sizes;
    Args a{};
    for (int i = 0; i < 21; ++i) a.in[i] = (const float*)d_in[i];
    a.out = (float*)d_out; a.ws = (unsigned char*)d_ws;
#if MK_ONE_LAUNCH
    if (hipMemsetAsync((char*)d_ws + WS_CTL, 0, CTL_BYTES, stream) != hipSuccess) return;
    hipLaunchKernelGGL(fwd, dim3(grid), dim3(512), LDS_BYTES, stream, a);
#else
    if (hipMemsetAsync((char*)d_ws + WS_CTL, 0, CTL_BYTES, stream) != hipSuccess) return;
    launch_one<K_PRO>(grid, stream, a, 0, 0);
    for (int l = 0; l < DEPTH; ++l) {
        for (int hf = 0; hf < NHALF; ++hf) {
            launch_one<K_A>(grid, stream, a, l, hf); launch_one<K_B>(grid, stream, a, l, hf); launch_one<K_C>(grid, stream, a, l, hf); launch_one<K_D>(grid, stream, a, l, hf);
            launch_one<K_E>(grid, stream, a, l, hf); launch_one<K_F>(grid, stream, a, l, hf); launch_one<K_G>(grid, stream, a, l, hf);
            if (l & 1) { launch_one<K_H1>(grid, stream, a, l, hf); launch_one<K_H2>(grid, stream, a, l, hf); launch_one<K_H3>(grid, stream, a, l, hf); launch_one<K_H4>(grid, stream, a, l, hf); }
        }
        if (!(l & 1)) { launch_one<K_H2>(grid, stream, a, l, 2); launch_one<K_H3>(grid, stream, a, l, 2); launch_one<K_H4>(grid, stream, a, l, 2); }
    }
#endif
}
```

```cpp
#include <hip/hip_runtime.h>
#include <cstdio>
#include <cstdint>

#ifndef MK_ONE_LAUNCH
#define MK_ONE_LAUNCH 1
#endif

#ifndef WGM_A
#define WGM_A 4
#endif
#ifndef WGM_F
#define WGM_F 4
#endif
#ifndef EXP_ZERO_DSA
#define EXP_ZERO_DSA 0
#endif
#ifndef EXP_ZERO_MLSTM
#define EXP_ZERO_MLSTM 0
#endif
#define LAS __attribute__((address_space(3)))
typedef unsigned short bf16_t;
typedef short bf16x8 __attribute__((ext_vector_type(8)));
typedef float f32x4 __attribute__((ext_vector_type(4)));
typedef float f32x16 __attribute__((ext_vector_type(16)));
typedef unsigned u32x4 __attribute__((ext_vector_type(4)));
typedef unsigned u32x2 __attribute__((ext_vector_type(2)));

constexpr int D = 1024, BATCH = 8, SEQ = 8192, DEPTH = 4;
constexpr int MH = 4 * SEQ;
constexpr int NHALF = 2;
constexpr int NP = 5120;
constexpr int C_QK = 0, C_V = 512, C_O = 1024, C_QL = 1536, C_BC = 2560, C_IQ = 2688, C_IK = 2944, C_GA = 2976, C_GB = 4000, C_IF = 5024, C_IW = 5032, C_END = 5040;
constexpr int DIN = 4528;
constexpr int DFF = 2816, DFE = 3584, NEXP = 8;
constexpr float DN_ALPHA = 1.681792830507429f;
constexpr float LN_EPS = 1e-5f;
constexpr int MOE_ROWS = 2 * MH + NEXP * 256;
constexpr int MOE_BLKS = MOE_ROWS / 256;

constexpr size_t MiB = 1u << 20;
constexpr size_t WS_CTL = 0, CTL_BYTES = 1 * MiB;
constexpr size_t WS_MISC = 1 * MiB;
constexpr size_t WS_WMIX = 5 * MiB;
constexpr size_t WMIX_LAYER = 15 * MiB, WM_IN = 0, WM_A = 10 * MiB, WM_OB = 11 * MiB, WM_OUT = 13 * MiB;
constexpr size_t WS_WFFN = 65 * MiB;
constexpr size_t WF_GU_E = (size_t)2 * DFE * D * 2, WF_D_OFF = (size_t)NEXP * WF_GU_E, WF_D_E = (size_t)D * DFE * 2;
constexpr size_t WS_XB = 233 * MiB;
constexpr size_t WS_R0 = 361 * MiB;
constexpr size_t WS_PROJ = WS_R0;
constexpr size_t WS_CKV = 681 * MiB;
constexpr size_t WS_SIDE = 689 * MiB;
constexpr size_t WS_SKV = 691 * MiB;
constexpr size_t WS_SN = 755 * MiB;
constexpr size_t WS_SSC = 756 * MiB;
constexpr size_t WS_IDX = 757 * MiB;
constexpr size_t WS_IKP = 773 * MiB;
constexpr size_t WS_PRE = WS_SKV;
constexpr size_t WS_YA = 776 * MiB;
constexpr size_t WS_OL = 808 * MiB;
constexpr size_t WS_MG = 872 * MiB;
constexpr size_t WS_GB = 936 * MiB;
constexpr size_t WS_PRE2 = 776 * MiB;
constexpr size_t WS_HD = WS_R0;
constexpr size_t WS_XS = WS_R0;
constexpr size_t WS_HM = 493 * MiB;
constexpr size_t WS_END = 1000 * MiB;
constexpr size_t MS_TE = 0;
constexpr size_t MS_TG = 256 * 1024;
constexpr size_t MS_TD = 512 * 1024;
constexpr size_t MS_RG = 768 * 1024;
constexpr size_t MS_WGC = 1100 * 1024;
constexpr size_t MS_META = 1200 * 1024;
constexpr int CW_BAR = 4096;

constexpr int LDS_MAIN = 131072;
constexpr int LDS_AUX = LDS_MAIN;
constexpr int LDS_CTLW = LDS_MAIN + 14336;
constexpr int LDS_BYTES = 147456;

__device__ __forceinline__ unsigned cvt_pk_bf16(float lo, float hi) { unsigned r; asm volatile("v_cvt_pk_bf16_f32 %0, %1, %2" : "=v"(r) : "v"(lo), "v"(hi)); return r; }
__device__ __forceinline__ unsigned pk2(float lo, float hi) { return cvt_pk_bf16(lo, hi); }
__device__ __forceinline__ unsigned f2bf(float f) { return cvt_pk_bf16(f, 0.f) & 0xffffu; }
__device__ __forceinline__ float bf2f(unsigned short b) { return __builtin_bit_cast(float, ((unsigned)b) << 16); }
__device__ __forceinline__ float bflo(unsigned w) { return __builtin_bit_cast(float, w << 16); }
__device__ __forceinline__ float bfhi(unsigned w) { return __builtin_bit_cast(float, w & 0xffff0000u); }
__device__ __forceinline__ float sigmoidf_(float x) { return __builtin_amdgcn_rcpf(1.f + __builtin_amdgcn_exp2f(x * -1.4426950408889634f)); }
template <int CTRL> __device__ __forceinline__ float dpp_mov(float x) { return __int_as_float(__builtin_amdgcn_mov_dpp(__float_as_int(x), CTRL, 0xf, 0xf, true)); }
__device__ __forceinline__ float row16_sum(float x) { x += dpp_mov<0x128>(x); x += dpp_mov<0x124>(x); x += dpp_mov<0x4E>(x); x += dpp_mov<0xB1>(x); return x; }
__device__ __forceinline__ float wave_sum(float v) {
    { auto s = __builtin_amdgcn_permlane32_swap(__float_as_uint(v), __float_as_uint(v), false, false); const unsigned s0 = s[0], s1 = s[1]; v = __uint_as_float(s0) + __uint_as_float(s1); }
    { auto s = __builtin_amdgcn_permlane16_swap(__float_as_uint(v), __float_as_uint(v), false, false); const unsigned s0 = s[0], s1 = s[1]; v = __uint_as_float(s0) + __uint_as_float(s1); }
    return row16_sum(v);
}
__device__ __forceinline__ unsigned mbcnt64(unsigned long long m) { return __builtin_amdgcn_mbcnt_hi((unsigned)(m >> 32), __builtin_amdgcn_mbcnt_lo((unsigned)m, 0u)); }
#define LDS_WAIT() asm volatile("s_waitcnt lgkmcnt(0)" ::: "memory")
#define VM_WAIT() asm volatile("s_waitcnt vmcnt(0)" ::: "memory")

#define XB_TMO      128
#define XB_XCNT(j)  (256  + 64 * (j))
#define XB_XSUB(j)  (1280 + 64 * (j))
#define XB_XGEN(j)  (2304 + 64 * (j))
#define XB_TOP      3328
#define XB_TOPGEN   3392
#define XCD_BAR_WORDS 3456
#define XB_SPIN_CAP (1u << 18)
__device__ __forceinline__ unsigned xb_ld(unsigned* p)              { return __hip_atomic_load(p, __ATOMIC_RELAXED, __HIP_MEMORY_SCOPE_AGENT); }
__device__ __forceinline__ unsigned xb_add(unsigned* p, unsigned v) { return __hip_atomic_fetch_add(p, v, __ATOMIC_RELAXED, __HIP_MEMORY_SCOPE_AGENT); }
__device__ __forceinline__ unsigned xb_xcc_id() { return (unsigned)__builtin_amdgcn_s_getreg((3 << 11) | 20) & 0xFu; }
#define XB_SPIN(cond, bar) do { unsigned _sp = 0; while (cond) { __builtin_amdgcn_s_sleep(1); \
    if ((++_sp & 255u) == 0u) { if (xb_ld(&(bar)[XB_TMO])) break; if (_sp > XB_SPIN_CAP) { atomicAdd(&(bar)[XB_TMO], 1u); break; } } } } while (0)
struct XcdBarrier { unsigned* bar; unsigned x; volatile LAS unsigned* st; };
__device__ __forceinline__ XcdBarrier xcd_barrier_post(unsigned* bar, volatile LAS unsigned* st) {
    XcdBarrier b; b.bar = bar; b.x = xb_xcc_id(); b.st = st;
    if (threadIdx.x == 0) (void)xb_add(&bar[XB_XCNT(b.x)], 1u);
    return b;
}
__device__ __forceinline__ void xcd_barrier_complete(unsigned* bar, unsigned x, unsigned& nloc, unsigned& nx) {
    const unsigned G = gridDim.x * gridDim.y * gridDim.z;
    unsigned sum, cnt, mine, sp = 0u;
    for (;;) {
        sum = 0u; cnt = 0u; mine = 0u;
#pragma unroll
        for (unsigned j = 0; j < 16; ++j) { const unsigned c = xb_ld(&bar[XB_XCNT(j)]); sum += c; cnt += (c > 0u) ? 1u : 0u; mine = (j == x) ? c : mine; }
        if (sum == G) break;
        __builtin_amdgcn_s_sleep(1);
        if ((++sp & 255u) == 0u) { if (xb_ld(&bar[XB_TMO])) break; if (sp > XB_SPIN_CAP) { atomicAdd(&bar[XB_TMO], 1u); break; } }
    }
    nloc = mine > 0u ? mine : 1u; nx = cnt > 0u ? cnt : 1u;
}
__device__ __attribute__((noinline)) void xcd_barrier(const XcdBarrier b) {
    asm volatile("s_waitcnt vmcnt(0)" ::: "memory");
    __syncthreads();
    if (threadIdx.x == 0) {
        unsigned* bar = b.bar;
        __builtin_amdgcn_s_waitcnt(0);
        unsigned nloc = b.st[0], nx = b.st[1];
        if (nloc == 0u) { xcd_barrier_complete(bar, b.x, nloc, nx); b.st[0] = nloc; b.st[1] = nx; }
        const unsigned old = xb_add(&bar[XB_XSUB(b.x)], 1u);
        const unsigned gen = old / nloc;
        if (old + 1u == (gen + 1u) * nloc) {
            __builtin_amdgcn_fence(__ATOMIC_RELEASE, "agent");
            asm volatile("s_waitcnt vmcnt(0)" ::: "memory");
            const unsigned og = xb_add(&bar[XB_TOP], 1u);
            const unsigned tg = og / nx;
            if (og + 1u == (tg + 1u) * nx) xb_add(&bar[XB_TOPGEN], 1u);
            else XB_SPIN(xb_ld(&bar[XB_TOPGEN]) == tg, bar);
            __builtin_amdgcn_fence(__ATOMIC_ACQUIRE, "agent");
            xb_add(&bar[XB_XGEN(b.x)], 1u);
            asm volatile("s_waitcnt vmcnt(0)" ::: "memory");
        } else {
            XB_SPIN(xb_ld(&bar[XB_XGEN(b.x)]) == gen, bar);
            __builtin_amdgcn_fence(__ATOMIC_ACQUIRE, "agent");
            asm volatile("s_waitcnt vmcnt(0)" ::: "memory");
        }
    }
    __syncthreads();
}

namespace pg8 {
constexpr int BM = 256, BK = 64, HALF = 128, HTB = HALF * BK * 2, STAGE_BYTES = 8 * HTB, NXCD = 8, WGM = 4;
__host__ __device__ __forceinline__ int lds_byte(int r, int c) { const int st = (r >> 4) * 2 + (c >> 5), rr = r & 15, cc = c & 31, ob = rr * 64 + cc * 2; return st * 1024 + (ob ^ (((ob >> 9) & 1) << 5)); }
__host__ __device__ __forceinline__ void stage_rc(int b, int& R, int& C) { const int st = b / 1024, sb = b % 1024, swz = sb ^ (((sb >> 9) & 1) << 5); R = (st >> 1) * 16 + swz / 64; C = (st & 1) * 32 + (swz % 64) / 2; }
__host__ __device__ __forceinline__ int perm32(int rho) { const int n = rho >> 4, i = rho & 15; return 8 * (i >> 2) + 4 * n + (i & 3); }
struct Unit { int pm, pn; };
struct Gemm { const bf16_t* A; const bf16_t* Bt; int lda, ldb, K; };
struct Order {
    int nM, nN, nwg, G, c, wgm; const unsigned* blk_e; size_t b_estride; size_t a_tstep, b_tstep;
    __device__ void init(int nM_, int nN_, int G_, int c_, const Gemm& g, const unsigned* be = nullptr, size_t bes = 0, int wgm_ = WGM) {
        nM = nM_; nN = nN_; nwg = nM * nN; G = G_; c = c_; wgm = wgm_; blk_e = be; b_estride = bes; a_tstep = (size_t)BM * g.lda * 2; b_tstep = (size_t)BM * g.ldb * 2; }
    __device__ bool next(int i, Unit& u) const {
        const long L = (long)i * G + c; if (L >= nwg) return false;
        int wgid = (int)L; { const int q = nwg / NXCD, r = nwg % NXCD, xcd = wgid % NXCD, off = wgid / NXCD; wgid = (xcd < r ? xcd * (q + 1) : r * (q + 1) + (xcd - r) * q) + off; }
        const int nig = wgm * nN, gid = wgid / nig, fm = gid * wgm, gsz = (nM - fm) < wgm ? (nM - fm) : wgm;
        u.pm = fm + ((wgid % nig) % gsz); u.pn = (wgid % nig) / gsz; return true;
    }
    __device__ __forceinline__ size_t a_off(const Unit& u) const { return (size_t)u.pm * a_tstep; }
    __device__ __forceinline__ size_t b_off(const Unit& u) const { size_t o = (size_t)u.pn * b_tstep; if (blk_e) o += (size_t)__builtin_amdgcn_readfirstlane(blk_e[u.pm]) * b_estride; return o; }
};

template <class Epi>
__device__ __forceinline__ void gemm_phase(LAS unsigned char* lds, const Gemm g, const Order& S, const Epi& E, const int tid) {
    const int wid = __builtin_amdgcn_readfirstlane(tid >> 6), lane = tid & 63, wr = wid >> 2, wc = wid & 3, fr = lane & 15, fq = lane >> 4;
    const int K = g.K, nt = K / BK;
    unsigned voffA[2], voffB[2];
#pragma unroll
    for (int i = 0; i < 2; ++i) { int R, C; stage_rc(tid * 16 + i * 8192, R, C); const int Rb = Epi::PERM ? ((R & ~31) + perm32(R & 31)) : R;
        voffA[i] = (unsigned)(R * g.lda + C) * 2u; voffB[i] = (unsigned)(Rb * g.ldb + C) * 2u; }
    const size_t kstep = (size_t)(BK * 2);
    const size_t hstepA = (size_t)HALF * g.lda * 2, hstepB = (size_t)HALF * g.ldb * 2;
    const unsigned ldsw = (unsigned)wid * 1024u;
    const int aoff = lds_byte(wr * 64 + fr, fq * 8), boff = lds_byte(wc * 32 + fr, fq * 8);
#define PG8_SA(b, h) (((b) * 2 + (h)) * HTB)
#define PG8_SB(b, h) ((4 + (b) * 2 + (h)) * HTB)
#define PG8_STAGE(bufoff, gbase, voff) do { _Pragma("unroll") for (int _i = 0; _i < 2; ++_i) \
        __builtin_amdgcn_global_load_lds((const unsigned*)((const char*)(gbase) + (voff)[_i]), (LAS unsigned*)(lds + (bufoff) + ldsw + _i * 8192), 16, 0, 0); } while (0)
#define PG8_LDA(dst, b, h) do { _Pragma("unroll") for (int m = 0; m < 4; ++m) _Pragma("unroll") for (int k = 0; k < 2; ++k) dst[m][k] = *(const LAS bf16x8*)(lds + PG8_SA(b, h) + aoff + m * 2048 + k * 1024); } while (0)
#define PG8_LDB(dst, b, h) do { _Pragma("unroll") for (int n = 0; n < 2; ++n) _Pragma("unroll") for (int k = 0; k < 2; ++k) dst[n][k] = *(const LAS bf16x8*)(lds + PG8_SB(b, h) + boff + n * 2048 + k * 1024); } while (0)
#define PG8_MMA(ai, bj, At, Bt) do { __builtin_amdgcn_s_setprio(1); _Pragma("unroll") for (int m = 0; m < 4; ++m) _Pragma("unroll") for (int n = 0; n < 2; ++n) _Pragma("unroll") for (int k = 0; k < 2; ++k) \
        acc[ai][bj][m][n] = __builtin_amdgcn_mfma_f32_16x16x32_bf16(Bt[n][k], At[m][k], acc[ai][bj][m][n], 0, 0, 0); __builtin_amdgcn_s_setprio(0); } while (0)
#define PG8_WAIT_V(n) asm volatile("s_waitcnt vmcnt(" #n ")" ::: "memory")
#define PG8_WAIT_L(n) asm volatile("s_waitcnt lgkmcnt(" #n ")" ::: "memory")
#define PG8_BAR __builtin_amdgcn_s_barrier()
#define PG8_SCHED __builtin_amdgcn_sched_barrier(0)
    Unit cur, nxt; int ui = 0;
    if (!S.next(0, cur)) return;
    f32x4 acc[2][2][4][2];
#pragma unroll
    for (int a = 0; a < 2; ++a)
#pragma unroll
        for (int b = 0; b < 2; ++b)
#pragma unroll
            for (int m = 0; m < 4; ++m)
#pragma unroll
                for (int n = 0; n < 2; ++n) acc[a][b][m][n] = (f32x4){0.f, 0.f, 0.f, 0.f};
    bf16x8 At[4][2], B0[2][2], B1[2][2];
    const char* cA = (const char*)g.A + S.a_off(cur); const char* cB = (const char*)g.Bt + S.b_off(cur);
    PG8_STAGE(PG8_SB(0, 0), cB, voffB); PG8_STAGE(PG8_SB(0, 1), cB + hstepB, voffB); PG8_STAGE(PG8_SA(0, 0), cA, voffA); PG8_STAGE(PG8_SA(0, 1), cA + hstepA, voffA);
    if (wr == 1) PG8_BAR;
    PG8_WAIT_V(2); PG8_BAR;
    PG8_STAGE(PG8_SB(1, 0), cB + kstep, voffB); PG8_STAGE(PG8_SA(1, 0), cA + kstep, voffA); PG8_STAGE(PG8_SB(1, 1), cB + hstepB + kstep, voffB);
    PG8_WAIT_V(6); PG8_BAR;
    for (;;) {
        const bool has_next = S.next(ui + 1, nxt);
        const char* nA = has_next ? (const char*)g.A + S.a_off(nxt) : cA; const char* nB = has_next ? (const char*)g.Bt + S.b_off(nxt) : cB;
        for (int t = 0; t < nt; t += 2) {
            const bool last = (t == nt - 2);
            const char* a1 = cA + (size_t)(t + 1) * kstep;
            const char* a2 = last ? nA : cA + (size_t)(t + 2) * kstep; const char* b2 = last ? nB : cB + (size_t)(t + 2) * kstep;
            const char* a3 = a2 + kstep; const char* b3 = b2 + kstep;
            PG8_LDB(B0, 0, 0); PG8_LDB(B1, 0, 1); PG8_SCHED; PG8_LDA(At, 0, 0); PG8_STAGE(PG8_SA(1, 1), a1 + hstepA, voffA);
            PG8_WAIT_V(8); PG8_WAIT_L(0); PG8_BAR; PG8_MMA(0, 0, At, B0); PG8_MMA(0, 1, At, B1); PG8_BAR; PG8_SCHED;
            PG8_LDA(At, 0, 1); PG8_STAGE(PG8_SB(0, 0), b2, voffB); PG8_STAGE(PG8_SB(0, 1), b2 + hstepB, voffB); PG8_STAGE(PG8_SA(0, 0), a2, voffA);
            PG8_WAIT_V(8); PG8_WAIT_L(0); PG8_BAR; PG8_MMA(1, 0, At, B0); PG8_MMA(1, 1, At, B1); PG8_BAR; PG8_SCHED;
            PG8_LDB(B0, 1, 0); PG8_LDB(B1, 1, 1); PG8_SCHED; PG8_LDA(At, 1, 0); PG8_STAGE(PG8_SA(0, 1), a2 + hstepA, voffA);
            PG8_WAIT_V(8); PG8_WAIT_L(0); PG8_BAR; PG8_MMA(0, 0, At, B0); PG8_MMA(0, 1, At, B1); PG8_BAR; PG8_SCHED;
            PG8_LDA(At, 1, 1); PG8_STAGE(PG8_SB(1, 0), b3, voffB); PG8_STAGE(PG8_SB(1, 1), b3 + hstepB, voffB); PG8_STAGE(PG8_SA(1, 0), a3, voffA);
            PG8_WAIT_V(8); PG8_WAIT_L(0); PG8_BAR; PG8_MMA(1, 0, At, B0); PG8_MMA(1, 1, At, B1); PG8_BAR; PG8_SCHED;
        }
        if (wr == 0) PG8_BAR;
        E(acc, cur, wr, wc, fr, fq);
        if (!has_next) break;
#pragma unroll
        for (int a = 0; a < 2; ++a)
#pragma unroll
            for (int b = 0; b < 2; ++b)
#pragma unroll
                for (int m = 0; m < 4; ++m)
#pragma unroll
                    for (int n = 0; n < 2; ++n) acc[a][b][m][n] = (f32x4){0.f, 0.f, 0.f, 0.f};
        cur = nxt; cA = nA; cB = nB; ++ui;
        if (wr == 1) PG8_BAR;
    }
    PG8_WAIT_V(0);
    PG8_BAR;
#undef PG8_SA
#undef PG8_SB
#undef PG8_STAGE
#undef PG8_LDA
#undef PG8_LDB
#undef PG8_MMA
#undef PG8_WAIT_V
#undef PG8_WAIT_L
#undef PG8_BAR
#undef PG8_SCHED
}

struct EpiInProj {
    static constexpr bool PERM = true;
    bf16_t* O; float* side; bf16_t* GA; bf16_t* GB;
    __device__ __forceinline__ void operator()(const f32x4 (&acc)[2][2][4][2], const Unit& u, int wr, int wc, int fr, int fq) const {
        const int row0 = u.pm * BM + wr * 64 + fr;
#pragma unroll
        for (int bj = 0; bj < 2; ++bj) {
            const int colw = __builtin_amdgcn_readfirstlane(u.pn * BM + bj * HALF + wc * 32), col = colw + 8 * fq;
            const bool sg = (colw >= C_GA) && (colw < C_IF);
            bf16_t* base = O + col; unsigned ld = NP;
            if (sg) { base = (colw < C_GB) ? GA + (col - C_GA) : GB + (col - C_GB); ld = D; }
            if (sg) {
#pragma unroll
                for (int ai = 0; ai < 2; ++ai)
#pragma unroll
                    for (int m = 0; m < 4; ++m) {
                        const unsigned row = (unsigned)(row0 + ai * HALF + m * 16);
                        f32x4 v0 = acc[ai][bj][m][0], v1 = acc[ai][bj][m][1];
#pragma unroll
                        for (int j = 0; j < 4; ++j) { v0[j] = sigmoidf_(v0[j]); v1[j] = sigmoidf_(v1[j]); }
                        u32x4 w; w.x = cvt_pk_bf16(v0[0], v0[1]); w.y = cvt_pk_bf16(v0[2], v0[3]); w.z = cvt_pk_bf16(v1[0], v1[1]); w.w = cvt_pk_bf16(v1[2], v1[3]);
                        __builtin_nontemporal_store(w, (u32x4*)(base + row * ld)); }
            } else {
#pragma unroll
                for (int ai = 0; ai < 2; ++ai)
#pragma unroll
                    for (int m = 0; m < 4; ++m) {
                        const unsigned row = (unsigned)(row0 + ai * HALF + m * 16);
                        const f32x4 v0 = acc[ai][bj][m][0], v1 = acc[ai][bj][m][1];
                        u32x4 w; w.x = cvt_pk_bf16(v0[0], v0[1]); w.y = cvt_pk_bf16(v0[2], v0[3]); w.z = cvt_pk_bf16(v1[0], v1[1]); w.w = cvt_pk_bf16(v1[2], v1[3]);
                        __builtin_nontemporal_store(w, (u32x4*)(base + row * ld)); }
                if (colw == C_IF && fq < 2) {
#pragma unroll
                    for (int ai = 0; ai < 2; ++ai)
#pragma unroll
                        for (int m = 0; m < 4; ++m) { const unsigned row = (unsigned)(row0 + ai * HALF + m * 16);
                            *(f32x4*)(side + (size_t)row * 16 + 8 * fq) = acc[ai][bj][m][0]; *(f32x4*)(side + (size_t)row * 16 + 8 * fq + 4) = acc[ai][bj][m][1]; }
                }
            }
        }
    }
};
template <int SECOND> struct EpiMerge {
    static constexpr bool PERM = true;
    bf16_t* MG; const bf16_t* GB;
    __device__ __forceinline__ void operator()(const f32x4 (&acc)[2][2][4][2], const Unit& u, int wr, int wc, int fr, int fq) const {
        const int row0 = u.pm * BM + wr * 64 + fr;
#pragma unroll
        for (int bj = 0; bj < 2; ++bj) {
            const int col = u.pn * BM + bj * HALF + wc * 32 + 8 * fq;
#pragma unroll
            for (int ai = 0; ai < 2; ++ai) {
                u32x4 ta[4], gb[4];
#pragma unroll
                for (int m = 0; m < 4; ++m) { const size_t o = (size_t)(row0 + ai * HALF + m * 16) * D + col; ta[m] = *(const u32x4*)(MG + o); if (SECOND) gb[m] = *(const u32x4*)(GB + o); }
#pragma unroll
                for (int m = 0; m < 4; ++m) {
                    const size_t o = (size_t)(row0 + ai * HALF + m * 16) * D + col;
                    const f32x4 v0 = acc[ai][bj][m][0], v1 = acc[ai][bj][m][1];
                    float r[8];
                    if (SECOND) {
                        r[0] = bflo(ta[m].x) + bflo(gb[m].x) * v0[0]; r[1] = bfhi(ta[m].x) + bfhi(gb[m].x) * v0[1]; r[2] = bflo(ta[m].y) + bflo(gb[m].y) * v0[2]; r[3] = bfhi(ta[m].y) + bfhi(gb[m].y) * v0[3];
                        r[4] = bflo(ta[m].z) + bflo(gb[m].z) * v1[0]; r[5] = bfhi(ta[m].z) + bfhi(gb[m].z) * v1[1]; r[6] = bflo(ta[m].w) + bflo(gb[m].w) * v1[2]; r[7] = bfhi(ta[m].w) + bfhi(gb[m].w) * v1[3];
                    } else {
                        r[0] = bflo(ta[m].x) * v0[0]; r[1] = bfhi(ta[m].x) * v0[1]; r[2] = bflo(ta[m].y) * v0[2]; r[3] = bfhi(ta[m].y) * v0[3];
                        r[4] = bflo(ta[m].z) * v1[0]; r[5] = bfhi(ta[m].z) * v1[1]; r[6] = bflo(ta[m].w) * v1[2]; r[7] = bfhi(ta[m].w) * v1[3]; }
                    u32x4 w; w.x = cvt_pk_bf16(r[0], r[1]); w.y = cvt_pk_bf16(r[2], r[3]); w.z = cvt_pk_bf16(r[4], r[5]); w.w = cvt_pk_bf16(r[6], r[7]);
                    *(u32x4*)(MG + o) = w; }
            }
        }
    }
};
struct EpiResid {
    static constexpr bool PERM = true;
    const bf16_t* XR; bf16_t* PRE;
    __device__ __forceinline__ void operator()(const f32x4 (&acc)[2][2][4][2], const Unit& u, int wr, int wc, int fr, int fq) const {
        const int row0 = u.pm * BM + wr * 64 + fr;
#pragma unroll
        for (int ai = 0; ai < 2; ++ai)
#pragma unroll
            for (int bj = 0; bj < 2; ++bj) { const int col = u.pn * BM + bj * HALF + wc * 32 + 8 * fq;
                u32x4 xv[4];
#pragma unroll
                for (int m = 0; m < 4; ++m) xv[m] = *(const u32x4*)(XR + (size_t)(row0 + ai * HALF + m * 16) * D + col);
#pragma unroll
                for (int m = 0; m < 4; ++m) { const u32x4 x = xv[m]; const f32x4 v0 = acc[ai][bj][m][0], v1 = acc[ai][bj][m][1];
                    u32x4 w; w.x = cvt_pk_bf16(bflo(x.x) * DN_ALPHA + v0[0], bfhi(x.x) * DN_ALPHA + v0[1]); w.y = cvt_pk_bf16(bflo(x.y) * DN_ALPHA + v0[2], bfhi(x.y) * DN_ALPHA + v0[3]);
                    w.z = cvt_pk_bf16(bflo(x.z) * DN_ALPHA + v1[0], bfhi(x.z) * DN_ALPHA + v1[1]); w.w = cvt_pk_bf16(bflo(x.w) * DN_ALPHA + v1[2], bfhi(x.w) * DN_ALPHA + v1[3]);
                    *(u32x4*)(PRE + (size_t)(row0 + ai * HALF + m * 16) * D + col) = w; } }
    }
};
struct EpiSwiglu {
    static constexpr bool PERM = true;
    bf16_t* H; int ldh;
    __device__ __forceinline__ void operator()(const f32x4 (&acc)[2][2][4][2], const Unit& u, int wr, int wc, int fr, int fq) const {
        const int row0 = u.pm * BM + wr * 64 + fr, col = u.pn * HALF + wc * 32 + 8 * fq;
#pragma unroll
        for (int ai = 0; ai < 2; ++ai)
#pragma unroll
            for (int m = 0; m < 4; ++m) {
                float r[8];
#pragma unroll
                for (int n = 0; n < 2; ++n)
#pragma unroll
                    for (int j = 0; j < 4; ++j) { const float gt = acc[ai][0][m][n][j], up = acc[ai][1][m][n][j]; r[4 * n + j] = gt * sigmoidf_(gt) * up; }
                u32x4 w; w.x = cvt_pk_bf16(r[0], r[1]); w.y = cvt_pk_bf16(r[2], r[3]); w.z = cvt_pk_bf16(r[4], r[5]); w.w = cvt_pk_bf16(r[6], r[7]);
                __builtin_nontemporal_store(w, (u32x4*)(H + (size_t)(row0 + ai * HALF + m * 16) * ldh + col)); }
    }
};
struct EpiMoeDown {
    static constexpr bool PERM = true;
    bf16_t* Y; const float* rg;
    __device__ __forceinline__ void operator()(const f32x4 (&acc)[2][2][4][2], const Unit& u, int wr, int wc, int fr, int fq) const {
        const int row0 = u.pm * BM + wr * 64 + fr;
#pragma unroll
        for (int ai = 0; ai < 2; ++ai)
#pragma unroll
            for (int m = 0; m < 4; ++m) { const int row = row0 + ai * HALF + m * 16; const float gsc = rg[row];
#pragma unroll
                for (int bj = 0; bj < 2; ++bj) { const int col = u.pn * BM + bj * HALF + wc * 32 + 8 * fq;
                    const f32x4 v0 = acc[ai][bj][m][0] * gsc, v1 = acc[ai][bj][m][1] * gsc;
                    u32x4 w; w.x = cvt_pk_bf16(v0[0], v0[1]); w.y = cvt_pk_bf16(v0[2], v0[3]); w.z = cvt_pk_bf16(v1[0], v1[1]); w.w = cvt_pk_bf16(v1[2], v1[3]);
                    *(u32x4*)(Y + (size_t)row * D + col) = w; } }
    }
};
}

struct Args { const float* in[21]; float* out; unsigned char* ws; int ph_lo, ph_hi; };
typedef const Args __attribute__((address_space(4)))* CArgs;
struct Frame {
    LAS unsigned char* lds;
    int tid, lane, wave, vcu, G, gw, NGW;
    CArgs ap; float* out; unsigned char* ws;
};
enum { I_X = 0, I_WIN, I_CONVW, I_GBIAS, I_NORMG, I_KVNG, I_WUK, I_WUV, I_RELB, I_WBA, I_WBB, I_WOUT, I_LNG, I_LNB, I_DWG, I_DWU, I_DWD, I_RW, I_EWG, I_EWU, I_EWD };

template <class F>
__device__ __forceinline__ void transpose_item(const F& val, int K, bf16_t* WT, LAS float* scr, int k0, int n0, int lane) {
    bool folded = false;
    if constexpr (F::HAS_FOLD) { folded = val.folded(n0);
    if (folded) {
        float bq[64];
#pragma unroll
        for (int d = 0; d < 64; ++d) bq[d] = val.bval(k0, n0 + (lane & 31), d);
#pragma unroll 2
        for (int i = 0; i < 32; ++i) { const int kk = 2 * i + (lane >> 5); const float* a = val.arow(k0 + kk, n0); float s0 = 0.f, s1 = 0.f, s2 = 0.f, s3 = 0.f;
#pragma unroll
            for (int d = 0; d < 64; d += 4) { const f32x4 av = *(const f32x4*)(a + d); s0 += av[0] * bq[d]; s1 += av[1] * bq[d + 1]; s2 += av[2] * bq[d + 2]; s3 += av[3] * bq[d + 3]; }
            scr[kk * 33 + (lane & 31)] = (s0 + s1) + (s2 + s3); }
    } }
    if (!folded)
#pragma unroll
    for (int i0 = 0; i0 < 32; i0 += 16) {
        float tv[16];
#pragma unroll
        for (int i = 0; i < 16; ++i) tv[i] = val(k0 + 2 * (i0 + i) + (lane >> 5), n0 + (lane & 31));
#pragma unroll
        for (int i = 0; i < 16; ++i) scr[(2 * (i0 + i) + (lane >> 5)) * 33 + (lane & 31)] = tv[i];
    }
    LDS_WAIT(); asm volatile("" ::: "memory");
    const int c = lane & 7;
#pragma unroll
    for (int j = 0; j < 4; ++j) { const int n = (lane >> 3) + 8 * j; const LAS float* s = scr + (8 * c) * 33 + n;
        u32x4 o; o.x = pk2(s[0 * 33], s[1 * 33]); o.y = pk2(s[2 * 33], s[3 * 33]); o.z = pk2(s[4 * 33], s[5 * 33]); o.w = pk2(s[6 * 33], s[7 * 33]);
        *(u32x4*)(WT + (size_t)(n0 + n) * K + k0 + 8 * c) = o; }
    LDS_WAIT(); asm volatile("" ::: "memory");
}
struct ValPlain { static constexpr bool HAS_FOLD = false; const float* W; int ldw; __device__ __forceinline__ float operator()(int k, int n) const { return W[(size_t)k * ldw + n]; }
    __device__ __forceinline__ f32x4 val4(int k, int n) const { return __builtin_nontemporal_load((const f32x4*)(W + (size_t)k * ldw + n)); } };
struct ValInProj { const float* W; const float* uk;
    static constexpr bool HAS_FOLD = true;
    __device__ __forceinline__ bool folded(int n0) const { return n0 >= C_QL && n0 < C_BC; }
    __device__ __forceinline__ float bval(int, int c, int d) const { const int h = (c - C_QL) >> 7, cc = (c - C_QL) & 127; return uk[(size_t)h * 64 * 128 + d * 128 + cc]; }
    __device__ __forceinline__ const float* arow(int k, int n0) const { return W + (size_t)k * DIN + 1544 + 64 * ((n0 - C_QL) >> 7); }
    __device__ __forceinline__ float operator()(int k, int c) const {
        const float* wr = W + (size_t)k * DIN;
        if (c < C_QL) return wr[c];
        if (c < C_BC) { const int h = (c - C_QL) >> 7, cc = (c - C_QL) & 127; const float* a = wr + 1544 + 64 * h; const float* b = uk + (size_t)h * 64 * 128 + cc; float s = 0.f;
#pragma unroll 8
            for (int d = 0; d < 64; ++d) s += a[d] * b[d * 128]; return s; }
        if (c < C_IQ) return wr[2056 + (c - C_BC)];
        if (c < C_IK) return wr[2184 + (c - C_IQ)];
        if (c < C_GA) return wr[2440 + (c - C_IK)];
        if (c < C_GB) return wr[2480 + (c - C_GA)];
        if (c < C_IF) return wr[3504 + (c - C_GB)];
        if (c < C_IW) return wr[1536 + (c - C_IF)];
        if (c < C_END) return wr[2472 + (c - C_IW)];
        return 0.f; } };
struct ValOB { const float* uv; const float* wb;
    static constexpr bool HAS_FOLD = true;
    __device__ __forceinline__ bool folded(int) const { return true; }
    __device__ __forceinline__ float bval(int k0, int n, int d) const { return wb[(size_t)(64 * (k0 >> 7) + d) * D + n]; }
    __device__ __forceinline__ const float* arow(int k, int) const { return uv + (size_t)k * 64; }
    __device__ __forceinline__ float operator()(int k, int n) const { const int h = k >> 7; const float* a = uv + (size_t)k * 64; const float* b = wb + (size_t)(64 * h) * D + n; float s = 0.f;
#pragma unroll 8
        for (int d = 0; d < 64; ++d) s += a[d] * b[(size_t)d * D]; return s; } };
struct ValGU { static constexpr bool HAS_FOLD = false; const float* Wg; const float* Wu; int dff;
    __device__ __forceinline__ float operator()(int k, int n) const { const int pn = n >> 8, rr = n & 255; const int col = 128 * pn + (rr & 127); const long dlt = (rr < 128) ? 0l : (long)(Wu - Wg); return Wg[dlt + (long)k * dff + col]; }
    __device__ __forceinline__ f32x4 val4(int k, int n) const { const int pn = n >> 8, rr = n & 255; const int col = 128 * pn + (rr & 127); const long dlt = (rr < 128) ? 0l : (long)(Wu - Wg); return __builtin_nontemporal_load((const f32x4*)(Wg + dlt + (long)k * dff + col)); } };

template <class F>
__device__ __forceinline__ void convert_matrix(Frame& F_, const F& val, int K, int N, bf16_t* WT, int& item_base) {
    LAS float* scr = (LAS float*)(F_.lds + F_.wave * 16384);
    const int nkb = K / 64, nnb = N / 32, nitems = nkb * nnb;
    int first = F_.gw - (item_base % F_.NGW); if (first < 0) first += F_.NGW;
    for (int it = first; it < nitems; it += F_.NGW) { const int kb = it / nnb, nb = it % nnb; transpose_item(val, K, WT, scr, 64 * kb, 32 * nb, F_.lane); }
    item_base += nitems;
}

template <class F>
__device__ __forceinline__ void transpose_item64(const F& val, int K, bf16_t* WT, LAS float* scr, int k0, int n0, int lane) {
    const int nq = 4 * (lane & 15), kr = lane >> 4;
#pragma unroll
    for (int h = 0; h < 2; ++h) {
        f32x4 tv[8];
#pragma unroll
        for (int i = 0; i < 8; ++i) tv[i] = val.val4(k0 + 4 * (8 * h + i) + kr, n0 + nq);
#pragma unroll
        for (int i = 0; i < 8; ++i) { LAS float* d = scr + (4 * (8 * h + i) + kr) * 65 + nq; d[0] = tv[i][0]; d[1] = tv[i][1]; d[2] = tv[i][2]; d[3] = tv[i][3]; }
    }
    LDS_WAIT(); asm volatile("" ::: "memory");
    const int c = lane & 7;
#pragma unroll
    for (int j = 0; j < 8; ++j) { const int n = (lane >> 3) + 8 * j; const LAS float* s = scr + (8 * c) * 65 + n;
        u32x4 o; o.x = pk2(s[0 * 65], s[1 * 65]); o.y = pk2(s[2 * 65], s[3 * 65]); o.z = pk2(s[4 * 65], s[5 * 65]); o.w = pk2(s[6 * 65], s[7 * 65]);
        *(u32x4*)(WT + (size_t)(n0 + n) * K + k0 + 8 * c) = o; }
    LDS_WAIT(); asm volatile("" ::: "memory");
}
template <class F>
__device__ __forceinline__ void convert_matrix64(Frame& F_, const F& val, int K, int N, bf16_t* WT, int& item_base) {
    LAS float* scr = (LAS float*)(F_.lds + F_.wave * 16640);
    const int nkb = K / 64, nnb = N / 64, nitems = nkb * nnb;
    int first = F_.gw - (item_base % F_.NGW); if (first < 0) first += F_.NGW;
    for (int it = first; it < nitems; it += F_.NGW) { const int kb = it / nnb, nb = it % nnb; transpose_item64(val, K, WT, scr, 64 * kb, 64 * nb, F_.lane); }
    item_base += nitems;
}

template <int MODE, bool ROUTE>
__device__ __forceinline__ void ln_pass(Frame& F, int l, int which, int hf, const bf16_t* ys, const unsigned* tdest) {
    const float* g = F.ap->in[I_LNG] + (size_t)(l * 2 + which) * D; const float* b = F.ap->in[I_LNB] + (size_t)(l * 2 + which) * D;
    const bool whole = (hf == 2); if (whole) hf = 0;
    const int nrows = whole ? 2 * MH : MH;
    bf16_t* xb = (bf16_t*)(F.ws + WS_XB); const bf16_t* pre = (const bf16_t*)(F.ws + (whole ? WS_PRE2 : WS_PRE));
    const bool final_out = (l == DEPTH - 1) && (which == 1);
    LAS float* rw = (LAS float*)F.lds;
    LAS unsigned* lcnt = (LAS unsigned*)(F.lds + 32768);
    if (ROUTE) {
        const float* RW = F.ap->in[I_RW] + (size_t)(l >> 1) * D * NEXP;
        for (int idx = F.tid; idx < D * NEXP; idx += 512) { const int k = idx >> 3, e = idx & 7; rw[((((k >> 8) * 4 + (k & 3)) * 64 + ((k & 255) >> 2)) << 3) + e] = RW[idx]; }
        if (F.tid < 8) lcnt[F.tid] = 0u;
        __syncthreads();
    }
    f32x4 gv[4], bv[4];
#pragma unroll
    for (int j = 0; j < 4; ++j) { gv[j] = *(const f32x4*)(g + 4 * F.lane + 256 * j); bv[j] = *(const f32x4*)(b + 4 * F.lane + 256 * j); }
    for (int r = F.gw; r < nrows; r += F.NGW) {
        const size_t grow = (size_t)hf * MH + r;
        f32x4 v[4]; float s = 0.f;
        if (MODE == 0) {
#pragma unroll
            for (int j = 0; j < 4; ++j) { const u32x2 a = *(const u32x2*)(pre + (size_t)r * D + 4 * F.lane + 256 * j); v[j] = (f32x4){bflo(a.x), bfhi(a.x), bflo(a.y), bfhi(a.y)}; }
        } else {
            const unsigned d0 = tdest[2 * r], d1 = tdest[2 * r + 1];
            const bf16_t* y0 = ys + (size_t)d0 * D + 4 * F.lane; const bf16_t* y1 = ys + (size_t)d1 * D + 4 * F.lane; const bf16_t* xr = xb + grow * D + 4 * F.lane;
#pragma unroll
            for (int j = 0; j < 4; ++j) { const u32x2 a = *(const u32x2*)(y0 + 256 * j), c = *(const u32x2*)(y1 + 256 * j), x = *(const u32x2*)(xr + 256 * j);
                v[j][0] = bflo(x.x) * DN_ALPHA + (bflo(a.x) + bflo(c.x)); v[j][1] = bfhi(x.x) * DN_ALPHA + (bfhi(a.x) + bfhi(c.x));
                v[j][2] = bflo(x.y) * DN_ALPHA + (bflo(a.y) + bflo(c.y)); v[j][3] = bfhi(x.y) * DN_ALPHA + (bfhi(a.y) + bfhi(c.y)); }
        }
#pragma unroll
        for (int j = 0; j < 4; ++j) s += (v[j][0] + v[j][1]) + (v[j][2] + v[j][3]);
        const float mean = wave_sum(s) * (1.f / D); float s2 = 0.f;
#pragma unroll
        for (int j = 0; j < 4; ++j) { v[j] = v[j] - mean; s2 += (v[j][0] * v[j][0] + v[j][1] * v[j][1]) + (v[j][2] * v[j][2] + v[j][3] * v[j][3]); }
        const float rstd = __builtin_amdgcn_rsqf(wave_sum(s2) * (1.f / D) + LN_EPS);
#pragma unroll
        for (int j = 0; j < 4; ++j) { v[j] = v[j] * rstd * gv[j] + bv[j];
            if (final_out) *(f32x4*)(F.out + grow * D + 4 * F.lane + 256 * j) = v[j];
            u32x2 w; w.x = cvt_pk_bf16(v[j][0], v[j][1]); w.y = cvt_pk_bf16(v[j][2], v[j][3]); *(u32x2*)(xb + grow * D + 4 * F.lane + 256 * j) = w; }
        if (ROUTE) {
            float lg[8];
#pragma unroll
            for (int e = 0; e < 8; ++e) lg[e] = 0.f;
#pragma unroll
            for (int j = 0; j < 4; ++j)
#pragma unroll
                for (int i = 0; i < 4; ++i) { const LAS float* w = rw + (((j * 4 + i) * 64 + F.lane) << 3); const f32x4 w0 = *(const LAS f32x4*)w, w1 = *(const LAS f32x4*)(w + 4); const float xv = v[j][i];
                    lg[0] += xv * w0[0]; lg[1] += xv * w0[1]; lg[2] += xv * w0[2]; lg[3] += xv * w0[3]; lg[4] += xv * w1[0]; lg[5] += xv * w1[1]; lg[6] += xv * w1[2]; lg[7] += xv * w1[3]; }
            {
                float h4[4], w2[2];
#pragma unroll
                for (int e = 0; e < 4; ++e) { auto s = __builtin_amdgcn_permlane32_swap(__float_as_uint(lg[e]), __float_as_uint(lg[e + 4]), false, false); const unsigned s0 = s[0], s1 = s[1]; h4[e] = __uint_as_float(s0) + __uint_as_float(s1); }
#pragma unroll
                for (int i = 0; i < 2; ++i) { auto s = __builtin_amdgcn_permlane16_swap(__float_as_uint(h4[i]), __float_as_uint(h4[i + 2]), false, false); const unsigned s0 = s[0], s1 = s[1]; w2[i] = row16_sum(__uint_as_float(s0) + __uint_as_float(s1)); }
#pragma unroll
                for (int i = 0; i < 2; ++i) {
                    lg[i] = __uint_as_float(__builtin_amdgcn_readlane(__float_as_uint(w2[i]), 0)); lg[2 + i] = __uint_as_float(__builtin_amdgcn_readlane(__float_as_uint(w2[i]), 16));
                    lg[4 + i] = __uint_as_float(__builtin_amdgcn_readlane(__float_as_uint(w2[i]), 32)); lg[6 + i] = __uint_as_float(__builtin_amdgcn_readlane(__float_as_uint(w2[i]), 48)); }
            }
            int e1 = 0; float l1 = lg[0];
#pragma unroll
            for (int e = 1; e < 8; ++e) if (lg[e] > l1) { l1 = lg[e]; e1 = e; }
            int e2 = -1; float l2 = -3.0e38f;
#pragma unroll
            for (int e = 0; e < 8; ++e) if (e != e1 && lg[e] > l2) { l2 = lg[e]; e2 = e; }
            if (F.lane == 0) {
                const float t = __expf(l2 - l1), p1 = 1.f / (1.f + t), p2 = t / (1.f + t);
                ((unsigned*)(F.ws + WS_MISC + MS_TE))[r] = (unsigned)e1 | ((unsigned)e2 << 8);
                ((float*)(F.ws + WS_MISC + MS_TG))[2 * r] = p1; ((float*)(F.ws + WS_MISC + MS_TG))[2 * r + 1] = p2;
                atomicAdd((unsigned*)(lcnt + e1), 1u); atomicAdd((unsigned*)(lcnt + e2), 1u);
            }
        }
    }
    if (ROUTE) { __syncthreads(); if (F.tid < 8) ((unsigned*)(F.ws + WS_MISC + MS_WGC))[F.vcu * 8 + F.tid] = lcnt[F.tid]; }
}

__device__ __forceinline__ void moe_scatter(Frame& F, int hf) {
    LAS unsigned* sh = (LAS unsigned*)F.lds;
    const unsigned* wgc = (const unsigned*)(F.ws + WS_MISC + MS_WGC);
    if (F.tid < 8) { unsigned tot = 0, mine = 0; for (int g = 0; g < F.G; ++g) { const unsigned c = wgc[g * 8 + F.tid]; if (g == F.vcu) mine = tot; tot += c; } sh[16 + F.tid] = tot; sh[F.tid] = mine; sh[8 + F.tid] = 0u; }
    __syncthreads();
    if (F.tid == 0) { unsigned ps = 0; for (int e = 0; e < 8; ++e) { sh[24 + e] = ps; sh[e] += ps; ps += ((sh[16 + e] + 255u) >> 8) << 8; }
        if (F.vcu == 0) { unsigned* meta = (unsigned*)(F.ws + WS_MISC + MS_META); meta[0] = ps >> 8;
            for (int e = 0; e < 8; ++e) { const unsigned b0 = sh[24 + e] >> 8, nb = (sh[16 + e] + 255u) >> 8; for (unsigned j = 0; j < nb; ++j) meta[16 + b0 + j] = (unsigned)e; } } }
    __syncthreads();
    const unsigned* te = (const unsigned*)(F.ws + WS_MISC + MS_TE); const float* tg = (const float*)(F.ws + WS_MISC + MS_TG);
    unsigned* td = (unsigned*)(F.ws + WS_MISC + MS_TD); float* rg = (float*)(F.ws + WS_MISC + MS_RG);
    const bf16_t* xb = (const bf16_t*)(F.ws + WS_XB); bf16_t* xs = (bf16_t*)(F.ws + WS_XS);
    for (int r = F.gw; r < MH; r += F.NGW) {
        const unsigned ee = te[r]; const int e1 = ee & 255, e2 = (ee >> 8) & 255;
        unsigned d0 = 0, d1 = 0;
        if (F.lane == 0) { d0 = sh[e1] + atomicAdd((unsigned*)(sh + 8 + e1), 1u); d1 = sh[e2] + atomicAdd((unsigned*)(sh + 8 + e2), 1u);
            td[2 * r] = d0; td[2 * r + 1] = d1; rg[d0] = tg[2 * r]; rg[d1] = tg[2 * r + 1]; }
        d0 = __builtin_amdgcn_readfirstlane(d0); d1 = __builtin_amdgcn_readfirstlane(d1);
        const bf16_t* src = xb + ((size_t)hf * MH + r) * D + 16 * F.lane;
        const u32x4 a = *(const u32x4*)src, c = *(const u32x4*)(src + 8);
        *(u32x4*)(xs + (size_t)d0 * D + 16 * F.lane) = a; *(u32x4*)(xs + (size_t)d0 * D + 16 * F.lane + 8) = c;
        *(u32x4*)(xs + (size_t)d1 * D + 16 * F.lane) = a; *(u32x4*)(xs + (size_t)d1 * D + 16 * F.lane + 8) = c;
    }
}

__device__ __forceinline__ f32x4 mma16(const LAS bf16_t* A, int lda, const LAS bf16_t* Bt, int ldb, int ksteps, int lane) {
    f32x4 acc = (f32x4){0.f, 0.f, 0.f, 0.f};
    const LAS bf16_t* ap = A + (lane & 15) * lda + 8 * (lane >> 4);
    const LAS bf16_t* bp = Bt + (lane & 15) * ldb + 8 * (lane >> 4);
    for (int ks = 0; ks < ksteps; ++ks) {
        const bf16x8 a = *(const LAS bf16x8*)(ap + 32 * ks), b = *(const LAS bf16x8*)(bp + 32 * ks);
        acc = __builtin_amdgcn_mfma_f32_16x16x32_bf16(a, b, acc, 0, 0, 0);
    }
    return acc;
}
__device__ __forceinline__ float log_sigmoidf_(float x) { return fminf(x, 0.f) - log1pf(__expf(-fabsf(x))); }
__device__ __forceinline__ float siluf_(float x) { return x * sigmoidf_(x); }

__device__ __forceinline__ void conv8(const bf16_t* proj, const float* cw  , int row, int tseq, int ch0, float (&o)[8]) {
#pragma unroll
    for (int i = 0; i < 8; ++i) o[i] = 0.f;
#pragma unroll
    for (int j = 0; j < 4; ++j) {
        if (tseq - 3 + j >= 0) {
            const u32x4 v = *(const u32x4*)(proj + (size_t)(row - 3 + j) * NP + C_QK + ch0);
            const f32x4 w0 = *(const f32x4*)(cw + j * 512 + ch0), w1 = *(const f32x4*)(cw + j * 512 + ch0 + 4);
            o[0] += bflo(v.x) * w0[0]; o[1] += bfhi(v.x) * w0[1]; o[2] += bflo(v.y) * w0[2]; o[3] += bfhi(v.y) * w0[3];
            o[4] += bflo(v.z) * w1[0]; o[5] += bfhi(v.z) * w1[1]; o[6] += bflo(v.w) * w1[2]; o[7] += bfhi(v.w) * w1[3];
        }
    }
#pragma unroll
    for (int i = 0; i < 8; ++i) o[i] = siluf_(o[i]);
}

__device__ __forceinline__ size_t skv_idx(int u, int e) { return ((size_t)(((u >> 7) * 16 + (e >> 9)) * 128 + (u & 127))) * 512 + (e & 511); }
__device__ __forceinline__ void mlstm_local(Frame& F, int l) {
    const bf16_t* proj = (const bf16_t*)(F.ws + WS_PROJ); const float* side = (const float*)(F.ws + WS_SIDE);
    bf16_t* skv = (bf16_t*)(F.ws + WS_SKV); float* sn = (float*)(F.ws + WS_SN); float* ssc = (float*)(F.ws + WS_SSC);
    const float* cw = F.ap->in[I_CONVW] + (size_t)l * 4 * 512; const float* gbias = F.ap->in[I_GBIAS] + l * 8;
    LAS bf16_t* Vt = (LAS bf16_t*)F.lds;
    LAS bf16_t* Kwt = (LAS bf16_t*)(F.lds + 18432);
    LAS float* wsc = (LAS float*)(F.lds + 27648);
    const int lane = F.lane, g4 = lane >> 4;
    for (int u = F.vcu; u < 2048; u += F.G) {
        const int seq = u >> 7, c = u & 127, lb = seq >> 2, hd = seq & 3, r0 = lb * SEQ + 64 * c;
        if (F.wave == 0) {
            const int row = r0 + lane;
            const float ig = side[(size_t)row * 16 + hd] + gbias[hd];
            const float lf = log_sigmoidf_(side[(size_t)row * 16 + 4 + hd] + gbias[4 + hd]);
            float b = lf;
#pragma unroll
            for (int o = 1; o < 64; o <<= 1) { const float t = __shfl_up(b, o); if (lane >= o) b += t; }
            const float blast = __shfl(b, 63);
            const float gl = blast - b + ig;
            float mx = gl;
#pragma unroll
            for (int o = 1; o < 64; o <<= 1) mx = fmaxf(mx, __shfl_xor(mx, o));
            wsc[lane] = __expf(gl - mx);
            if (lane == 0) { ssc[u * 4 + 0] = mx; ssc[u * 4 + 1] = blast; }
        }
        __syncthreads();
        {
            const int s = F.tid >> 3, d8 = (F.tid & 7) * 8; float kv[8];
            conv8(proj, cw, r0 + s, 64 * c + s, 256 + hd * 64 + d8, kv);
            const float sc = 0.125f * wsc[s];
#pragma unroll
            for (int i = 0; i < 8; ++i) Kwt[(d8 + i) * 72 + s] = (bf16_t)f2bf(kv[i] * sc);
            const int v16 = (F.tid & 7) * 16;
            const u32x4 a = *(const u32x4*)(proj + (size_t)(r0 + s) * NP + C_V + hd * 128 + v16), b2 = *(const u32x4*)(proj + (size_t)(r0 + s) * NP + C_V + hd * 128 + v16 + 8);
            const unsigned w[8] = {a.x, a.y, a.z, a.w, b2.x, b2.y, b2.z, b2.w};
#pragma unroll
            for (int i = 0; i < 8; ++i) { Vt[(v16 + 2 * i) * 72 + s] = (bf16_t)(w[i] & 0xffffu); Vt[(v16 + 2 * i + 1) * 72 + s] = (bf16_t)(w[i] >> 16); }
        }
        __syncthreads();
        {
            const int w = F.wave;
            LAS float* stg = (LAS float*)(F.lds + 32768);
#pragma unroll
            for (int dt = 0; dt < 4; ++dt) {
                const f32x4 acc = mma16(Vt + 16 * w * 72, 72, Kwt + 16 * dt * 72, 72, 2, lane);
#pragma unroll
                for (int j = 0; j < 4; ++j) stg[(16 * w + 4 * g4 + j) * 64 + 16 * dt + (lane & 15)] = acc[j];
            }
            if (F.tid < 64) { float s = 0.f; for (int i = 0; i < 64; ++i) s += bf2f(Kwt[F.tid * 72 + i]); sn[u * 64 + F.tid] = s; }
            __syncthreads();
#pragma unroll
            for (int k = 0; k < 2; ++k) { const int e8 = 8 * (F.tid + 512 * k); const f32x4 a = *(const LAS f32x4*)(stg + e8), b = *(const LAS f32x4*)(stg + e8 + 4);
                *(u32x4*)(skv + skv_idx(u, e8)) = (u32x4){pk2(a[0], a[1]), pk2(a[2], a[3]), pk2(b[0], b[1]), pk2(b[2], b[3])}; }
        }
        __syncthreads();
    }
}

template <bool DUMMY>
__device__ __forceinline__ void mlstm_scan_t(Frame& F) {
    bf16_t* skv = (bf16_t*)(F.ws + WS_SKV); float* sn = (float*)(F.ws + WS_SN); float* ssc = (float*)(F.ws + WS_SSC);
    typedef float f32x2 __attribute__((ext_vector_type(2)));
    LAS f32x2* coef = (LAS f32x2*)F.lds;
    LAS float* raw = (LAS float*)(F.lds + 1024);
    for (int g0 = F.vcu * 512; g0 < 16 * 8192; g0 += F.G * 512) {
        const int seq = __builtin_amdgcn_readfirstlane(g0 >> 13), eb = g0 & 8191;
        const int e2 = eb + 2 * (F.tid & 255);
        unsigned* kvp = (unsigned*)(skv + skv_idx(seq * 128, e2)); float* snp = sn + (size_t)seq * 128 * 64 + (F.tid & 63); float* scp = ssc + (size_t)seq * 128 * 4;
        constexpr int UB = 16;
        unsigned kvA[UB], kvB[UB];
        if (F.tid < 256) {
#pragma unroll
            for (int i = 0; i < UB; ++i) kvA[i] = kvp[(size_t)i * 256]; }
        __syncthreads();
        if (F.tid < 128) { raw[2 * F.tid] = scp[F.tid * 4 + 0]; raw[2 * F.tid + 1] = scp[F.tid * 4 + 1]; }
        __syncthreads();
        if (F.tid == 0) { float m = 0.f;
            for (int c = 0; c < 128; ++c) { const float ml = raw[2 * c], bl = raw[2 * c + 1]; const float mn = fmaxf(bl + m, ml);
                coef[c] = (f32x2){__expf(bl + m - mn), __expf(ml - mn)}; if (!DUMMY && eb == 0) scp[c * 4 + 2] = m; m = mn; } }
        __syncthreads();
        if (F.tid < 256) {
            float C0 = 0.f, C1 = 0.f;
#define SCAN_BATCH(CUR, NXT, c0) do { \
            if ((c0) + UB < 128) { _Pragma("unroll") for (int i = 0; i < UB; ++i) NXT[i] = kvp[(size_t)((c0) + UB + i) * 256]; } \
            _Pragma("unroll") for (int i = 0; i < UB; ++i) { const int c = (c0) + i; const f32x2 cf = coef[c]; \
                (DUMMY ? kvp + (960 * MiB - WS_SKV) / 4 : kvp)[(size_t)c * 256] = pk2(C0, C1); C0 = cf.x * C0 + cf.y * bflo(CUR[i]); C1 = cf.x * C1 + cf.y * bfhi(CUR[i]); } } while (0)
            for (int c0 = 0; c0 < 128; c0 += 2 * UB) { SCAN_BATCH(kvA, kvB, c0); SCAN_BATCH(kvB, kvA, c0 + UB); }
#undef SCAN_BATCH
        } else if (!DUMMY && F.tid < 320 && eb == 0) {
            float n = 0.f, nv[16];
            for (int c0 = 0; c0 < 128; c0 += 16) {
#pragma unroll
                for (int i = 0; i < 16; ++i) nv[i] = snp[(c0 + i) * 64];
#pragma unroll
                for (int i = 0; i < 16; ++i) { const f32x2 cf = coef[c0 + i]; snp[(c0 + i) * 64] = n; n = cf.x * n + cf.y * nv[i]; } }
        }
    }
}

__device__ __forceinline__ void mlstm_scan(Frame& F) { mlstm_scan_t<false>(F); }

__device__ __forceinline__ void mlstm_out(Frame& F, int l) {
    bf16_t* proj = (bf16_t*)(F.ws + WS_PROJ); const float* side = (const float*)(F.ws + WS_SIDE);
    const bf16_t* skv = (const bf16_t*)(F.ws + WS_SKV); const float* sn = (const float*)(F.ws + WS_SN); const float* ssc = (const float*)(F.ws + WS_SSC);
    const float* cw = F.ap->in[I_CONVW] + (size_t)l * 4 * 512; const float* gbias = F.ap->in[I_GBIAS] + l * 8; const float* ng = F.ap->in[I_NORMG] + (size_t)l * 512;
    LAS bf16_t* Qs = (LAS bf16_t*)F.lds;
    LAS bf16_t* Ks = (LAS bf16_t*)(F.lds + 9216);
    LAS bf16_t* Sw = (LAS bf16_t*)(F.lds + 18432);
    LAS bf16_t* Vt = (LAS bf16_t*)(F.lds + 27648);
    LAS bf16_t* Ct = (LAS bf16_t*)(F.lds + 48384);
    LAS float* Hr = (LAS float*)(F.lds + 69120);
    LAS float* gB = (LAS float*)(F.lds + 107008);
    LAS float* gA = gB + 64;
    LAS float* gM = gB + 128;
    LAS float* gW = gB + 192;
    LAS float* gE = gB + 256;
    const int lane = F.lane, g4 = lane >> 4;
    for (int u = F.vcu; u < 2048; u += F.G) {
        const int seq = u >> 7, c = u & 127, lb = seq >> 2, hd = seq & 3, r0 = lb * SEQ + 64 * c;
        if (F.wave == 0) {
            const int row = r0 + lane;
            const float ig = side[(size_t)row * 16 + hd] + gbias[hd];
            const float lf = log_sigmoidf_(side[(size_t)row * 16 + 4 + hd] + gbias[4 + hd]);
            float b = lf;
#pragma unroll
            for (int o = 1; o < 64; o <<= 1) { const float t = __shfl_up(b, o); if (lane >= o) b += t; }
            const float a = ig - b;
            float pm = a;
#pragma unroll
            for (int o = 1; o < 64; o <<= 1) { const float t = __shfl_up(pm, o); if (lane >= o) pm = fmaxf(pm, t); }
            const float mst = ssc[u * 4 + 2];
            const float mt = fmaxf(b + mst, b + pm);
            gB[lane] = b; gA[lane] = a; gM[lane] = mt; gW[lane] = __expf(b + mst - mt); gE[lane] = __expf(-mt);
        }
        {
            const int s = F.tid >> 3, d8 = (F.tid & 7) * 8; float qv[8], kv[8];
            conv8(proj, cw, r0 + s, 64 * c + s, hd * 64 + d8, qv);
            conv8(proj, cw, r0 + s, 64 * c + s, 256 + hd * 64 + d8, kv);
            u32x4 wq, wk; wq.x = pk2(qv[0], qv[1]); wq.y = pk2(qv[2], qv[3]); wq.z = pk2(qv[4], qv[5]); wq.w = pk2(qv[6], qv[7]);
            wk.x = pk2(kv[0] * 0.125f, kv[1] * 0.125f); wk.y = pk2(kv[2] * 0.125f, kv[3] * 0.125f); wk.z = pk2(kv[4] * 0.125f, kv[5] * 0.125f); wk.w = pk2(kv[6] * 0.125f, kv[7] * 0.125f);
            *(LAS u32x4*)(Qs + s * 72 + d8) = wq; *(LAS u32x4*)(Ks + s * 72 + d8) = wk;
            const int v16 = (F.tid & 7) * 16;
            const u32x4 a = *(const u32x4*)(proj + (size_t)(r0 + s) * NP + C_V + hd * 128 + v16), b2 = *(const u32x4*)(proj + (size_t)(r0 + s) * NP + C_V + hd * 128 + v16 + 8);
            const unsigned w[8] = {a.x, a.y, a.z, a.w, b2.x, b2.y, b2.z, b2.w};
#pragma unroll
            for (int i = 0; i < 8; ++i) { Vt[(v16 + 2 * i) * 72 + s] = (bf16_t)(w[i] & 0xffffu); Vt[(v16 + 2 * i + 1) * 72 + s] = (bf16_t)(w[i] >> 16); }
            for (int i = F.tid; i < 16 * 64; i += 512) { const int rr = 128 + (i >> 6), cc = i & 63; Vt[rr * 72 + cc] = (bf16_t)(rr == 128 ? 0x3F80u : 0u); Ct[rr * 72 + cc] = (bf16_t)(rr == 128 ? f2bf(sn[u * 64 + cc]) : 0u); }
            const int v = F.tid >> 2, d16 = (F.tid & 3) * 16; const bf16_t* cp = skv + skv_idx(u, v * 64 + d16);
            const u32x4 o0 = *(const u32x4*)cp, o1 = *(const u32x4*)(cp + 8);
            *(LAS u32x4*)(Ct + v * 72 + d16) = o0; *(LAS u32x4*)(Ct + v * 72 + d16 + 8) = o1;
        }
        __syncthreads();
        {
            const int tt = F.wave >> 1;
#pragma unroll
            for (int i = 0; i < 2; ++i) { const int st = 2 * (F.wave & 1) + i;
                f32x4 acc = (f32x4){0.f, 0.f, 0.f, 0.f};
                if (st <= tt) acc = mma16(Qs + 16 * tt * 72, 72, Ks + 16 * st * 72, 72, 2, lane);
                const int s = 16 * st + (lane & 15); const float as = gA[s];
#pragma unroll
                for (int j = 0; j < 4; ++j) { const int t = 16 * tt + 4 * g4 + j; const float val = (s <= t) ? acc[j] * __expf(gB[t] - gM[t] + as) : 0.f; Sw[t * 72 + s] = (bf16_t)f2bf(val); } }
        }
        __syncthreads();
        {
            const int tt = F.wave & 3, v0 = (F.wave < 4) ? 0 : 5, v1 = (F.wave < 4) ? 5 : 9;
            for (int vt = v0; vt < v1; ++vt) {
                const f32x4 a1 = mma16(Sw + 16 * tt * 72, 72, Vt + 16 * vt * 72, 72, 2, lane);
                const f32x4 a2 = mma16(Qs + 16 * tt * 72, 72, Ct + 16 * vt * 72, 72, 2, lane);
#pragma unroll
                for (int j = 0; j < 4; ++j) { const int t = 16 * tt + 4 * g4 + j; Hr[t * 148 + 16 * vt + (lane & 15)] = a1[j] + gW[t] * a2[j]; } }
        }
        __syncthreads();
        {
            const int t = F.tid >> 3, v16 = (F.tid & 7) * 16;
            const float den = Hr[t * 148 + 128], dd = fmaxf(fabsf(den), gE[t]), inv = __builtin_amdgcn_rcpf(dd);
            float h[16], s = 0.f;
#pragma unroll
            for (int i = 0; i < 16; ++i) { h[i] = Hr[t * 148 + v16 + i] * inv; s += h[i]; }
            s += __shfl_xor(s, 1); s += __shfl_xor(s, 2); s += __shfl_xor(s, 4);
            const float mu = s * (1.f / 128.f); float q = 0.f;
#pragma unroll
            for (int i = 0; i < 16; ++i) { h[i] -= mu; q += h[i] * h[i]; }
            q += __shfl_xor(q, 1); q += __shfl_xor(q, 2); q += __shfl_xor(q, 4);
            const float rstd = __builtin_amdgcn_rsqf(q * (1.f / 128.f) + LN_EPS);
            bf16_t* rowp = proj + (size_t)(r0 + t) * NP;
            const u32x4 ao0 = *(const u32x4*)(rowp + C_O + hd * 128 + v16), ao1 = *(const u32x4*)(rowp + C_O + hd * 128 + v16 + 8);
            const unsigned aw[8] = {ao0.x, ao0.y, ao0.z, ao0.w, ao1.x, ao1.y, ao1.z, ao1.w};
            unsigned ow[8];
#pragma unroll
            for (int i = 0; i < 8; ++i) { const float y0 = h[2 * i] * rstd * ng[hd * 128 + v16 + 2 * i] * sigmoidf_(bflo(aw[i])), y1 = h[2 * i + 1] * rstd * ng[hd * 128 + v16 + 2 * i + 1] * sigmoidf_(bfhi(aw[i])); ow[i] = EXP_ZERO_MLSTM ? 0u : pk2(y0, y1); }
            bf16_t* yp = (bf16_t*)(F.ws + WS_YA) + (size_t)(r0 + t) * 512 + hd * 128 + v16;
            *(u32x4*)yp = (u32x4){ow[0], ow[1], ow[2], ow[3]}; *(u32x4*)(yp + 8) = (u32x4){ow[4], ow[5], ow[6], ow[7]};
        }
        __syncthreads();
    }
}

__device__ __forceinline__ void ckv_pass(Frame& F, int l) {
    const bf16_t* proj = (const bf16_t*)(F.ws + WS_PROJ); bf16_t* ckv = (bf16_t*)(F.ws + WS_CKV); bf16_t* ikp = (bf16_t*)(F.ws + WS_IKP);
    const float* kg = F.ap->in[I_KVNG] + (size_t)l * 128;
    const int l16 = F.lane & 15, rs = F.lane >> 4;
    const f32x4 g0 = *(const f32x4*)(kg + 8 * l16), g1 = *(const f32x4*)(kg + 8 * l16 + 4);
    for (int r4 = F.gw; r4 < MH / 4; r4 += F.NGW) {
        const int row = 4 * r4 + rs;
        const u32x4 v = *(const u32x4*)(proj + (size_t)row * NP + C_BC + 8 * l16);
        float x[8] = {bflo(v.x), bfhi(v.x), bflo(v.y), bfhi(v.y), bflo(v.z), bfhi(v.z), bflo(v.w), bfhi(v.w)};
        float ss = 0.f;
#pragma unroll
        for (int i = 0; i < 8; ++i) ss += x[i] * x[i];
        ss += __shfl_xor(ss, 1); ss += __shfl_xor(ss, 2); ss += __shfl_xor(ss, 4); ss += __shfl_xor(ss, 8);
        const float rr = __builtin_amdgcn_rsqf(ss * (1.f / 128.f) + LN_EPS);
        u32x4 o; o.x = pk2(x[0] * rr * g0[0], x[1] * rr * g0[1]); o.y = pk2(x[2] * rr * g0[2], x[3] * rr * g0[3]);
        o.z = pk2(x[4] * rr * g1[0], x[5] * rr * g1[1]); o.w = pk2(x[6] * rr * g1[2], x[7] * rr * g1[3]);
        *(u32x4*)(ckv + (size_t)row * 128 + 8 * l16) = o;
        if (l16 < 4) *(u32x4*)(ikp + (size_t)row * 32 + 8 * l16) = *(const u32x4*)(proj + (size_t)row * NP + C_IK + 8 * l16);
    }
}

__device__ __forceinline__ float relu_(float x) { const int xi = __float_as_int(x); return __int_as_float(xi > 0 ? xi : 0); }
__device__ __forceinline__ unsigned f2sort(unsigned u) { return u ^ ((unsigned)((int)u >> 31) | 0x80000000u); }
template <bool EXACT>
__device__ __forceinline__ int topk_compact(LAS u32x2* buf, int n, int lane, unsigned& thr_out) {
    unsigned u[8], ky[8];
#pragma unroll
    for (int j = 0; j < 8; ++j) { const int e = j * 64 + lane; u32x2 v = (u32x2){0u, 0u}; if (e < n) v = buf[e]; u[j] = v.x; ky[j] = v.y; }
    unsigned thr = 0u;
    for (int bit = 31; bit >= (EXACT ? 0 : 16); --bit) {
        const unsigned cand = thr | (1u << bit); int c = 0;
#pragma unroll
        for (int j = 0; j < 8; ++j) c += __popcll(__ballot(u[j] >= cand));
        if (c >= 256) thr = cand;
    }
    if (EXACT) {
        int cgt = 0;
#pragma unroll
        for (int j = 0; j < 8; ++j) cgt += __popcll(__ballot(u[j] > thr));
        const int need = 256 - cgt; int pos = 0, eqs = 0;
#pragma unroll
        for (int j = 0; j < 8; ++j) {
            const bool gt = u[j] > thr, eq = u[j] == thr;
            const unsigned long long meq = __ballot(eq);
            const bool keep = gt || (eq && (int)(eqs + mbcnt64(meq)) < need);
            const unsigned long long mk = __ballot(keep);
            if (keep) buf[pos + mbcnt64(mk)] = (u32x2){u[j], ky[j]};
            pos += __popcll(mk); eqs += __popcll(meq);
        }
        thr_out = thr; return 256;
    } else {
        int pos = 0;
#pragma unroll
        for (int j = 0; j < 8; ++j) {
            const bool keep = u[j] >= thr;
            const unsigned long long mk = __ballot(keep);
            if (keep) buf[pos + mbcnt64(mk)] = (u32x2){u[j], ky[j]};
            pos += __popcll(mk);
        }
        thr_out = thr - 1u; return pos;
    }
}
template <int VAR>
__device__ __forceinline__ void topk_phase_t(Frame& F, unsigned* qhead) {
    const bf16_t* proj = (const bf16_t*)(F.ws + WS_PROJ); const float* side = (const float*)(F.ws + WS_SIDE); const bf16_t* ikp = (const bf16_t*)(F.ws + WS_IKP);
    unsigned short* idxo = (unsigned short*)(F.ws + (VAR ? 1010 * MiB : WS_IDX));
    LAS u32x2* wb = (LAS u32x2*)(F.lds + F.wave * 16384);
    const int lane = F.lane, hh = lane >> 5;
    for (;;) {
        int rho = 0;
        if (lane == 0) rho = (int)__hip_atomic_fetch_add(qhead, 1u, __ATOMIC_RELAXED, __HIP_MEMORY_SCOPE_AGENT);
        rho = __builtin_amdgcn_readfirstlane(rho);
        if (rho >= 8192) break;
        const int lb = rho & 3, tg = 2047 - (rho >> 2);
        const int t0 = 4 * tg, rb = lb * SEQ;
        bf16x8 aq0, aq1;
        { const int q = (lane & 31) >> 3, h = lane & 7; const bf16_t* p = proj + (size_t)(rb + t0 + q) * NP + C_IQ + h * 32 + 8 * hh; aq0 = *(const bf16x8*)p; aq1 = *(const bf16x8*)(p + 16); }
        float wq[16];
#pragma unroll
        for (int r = 0; r < 16; ++r) wq[r] = side[(size_t)(rb + t0 + (r >> 2)) * 16 + 8 + (r & 3) + 4 * hh] * 0.0625f;
        unsigned tau_a = 0u, tau_b = 0u; int c0 = 0, c1 = 0, c2 = 0, c3 = 0;
        const int ntile = (t0 + 3) / 32 + 1, npair = (ntile + 1) >> 1;
        const bf16_t* kbase = ikp + (size_t)(rb + (lane & 31)) * 32 + 8 * hh;
        bf16x8 n1[4], n2[4];
#pragma unroll
        for (int i = 0; i < 2; ++i) { const int ja = (i < ntile) ? i : ntile - 1, jb = (2 + i < ntile) ? 2 + i : ntile - 1;
            n1[2 * i] = *(const bf16x8*)(kbase + (size_t)ja * 1024); n1[2 * i + 1] = *(const bf16x8*)(kbase + (size_t)ja * 1024 + 16);
            n2[2 * i] = *(const bf16x8*)(kbase + (size_t)jb * 1024); n2[2 * i + 1] = *(const bf16x8*)(kbase + (size_t)jb * 1024 + 16); }
        for (int jp = 0; jp < npair; ++jp) {
            bf16x8 bb[4];
#pragma unroll
            for (int i = 0; i < 4; ++i) { bb[i] = n1[i]; n1[i] = n2[i]; }
#pragma unroll
            for (int i = 0; i < 2; ++i) { const int jn = (2 * jp + 4 + i < ntile) ? 2 * jp + 4 + i : ntile - 1; n2[2 * i] = *(const bf16x8*)(kbase + (size_t)jn * 1024); n2[2 * i + 1] = *(const bf16x8*)(kbase + (size_t)jn * 1024 + 16); }
            if (c0 > 448) { unsigned t; c0 = topk_compact<false>(wb, c0, lane, t); if (c0 > 416) c0 = topk_compact<true>(wb, c0, lane, t); if (!hh) tau_a = t; }
            if (c1 > 448) { unsigned t; c1 = topk_compact<false>(wb + 512, c1, lane, t); if (c1 > 416) c1 = topk_compact<true>(wb + 512, c1, lane, t); if (!hh) tau_b = t; }
            if (c2 > 448) { unsigned t; c2 = topk_compact<false>(wb + 1024, c2, lane, t); if (c2 > 416) c2 = topk_compact<true>(wb + 1024, c2, lane, t); if (hh) tau_a = t; }
            if (c3 > 448) { unsigned t; c3 = topk_compact<false>(wb + 1536, c3, lane, t); if (c3 > 416) c3 = topk_compact<true>(wb + 1536, c3, lane, t); if (hh) tau_b = t; }
            f32x16 acc[2];
#pragma unroll
            for (int i = 0; i < 2; ++i) {
#pragma unroll
                for (int r = 0; r < 16; ++r) acc[i][r] = 0.f;
                acc[i] = __builtin_amdgcn_mfma_f32_32x32x16_bf16(aq0, bb[2 * i], acc[i], 0, 0, 0);
                acc[i] = __builtin_amdgcn_mfma_f32_32x32x16_bf16(aq1, bb[2 * i + 1], acc[i], 0, 0, 0); }
            unsigned ua[2], ub[2];
#pragma unroll
            for (int i = 0; i < 2; ++i) {
                float p[4];
#pragma unroll
                for (int q = 0; q < 4; ++q) { const float a0 = acc[i][4 * q], a1 = acc[i][4 * q + 1], a2 = acc[i][4 * q + 2], a3 = acc[i][4 * q + 3]; p[q] = (relu_(a0) * wq[4 * q] + relu_(a1) * wq[4 * q + 1]) + (relu_(a2) * wq[4 * q + 2] + relu_(a3) * wq[4 * q + 3]); }
                auto r02 = __builtin_amdgcn_permlane32_swap(__float_as_uint(p[0]), __float_as_uint(p[2]), false, false);
                auto r13 = __builtin_amdgcn_permlane32_swap(__float_as_uint(p[1]), __float_as_uint(p[3]), false, false);
                const unsigned r02a = r02[0], r02b = r02[1], r13a = r13[0], r13b = r13[1];
                ua[i] = f2sort(__float_as_uint(__uint_as_float(r02a) + __uint_as_float(r02b)));
                ub[i] = f2sort(__float_as_uint(__uint_as_float(r13a) + __uint_as_float(r13b)));
            }
#pragma unroll
            for (int i = 0; i < 2; ++i) {
                const int key = 32 * (2 * jp + i) + (lane & 31);
                {
                    const bool pa = (VAR == 3) ? false : (key <= t0 + 2 * hh) && (ua[i] > tau_a) && (VAR != 2 || (hh ? c2 : c0) < 440);
                    const unsigned long long m = __ballot(pa); const unsigned mlo = (unsigned)m, mhi = (unsigned)(m >> 32);
                    const unsigned off = hh ? __builtin_amdgcn_mbcnt_hi(mhi, 0u) : __builtin_amdgcn_mbcnt_lo(mlo, 0u);
                    if (pa) wb[(hh ? 1024 + c2 : c0) + off] = (u32x2){ua[i], (unsigned)key};
                    c0 += __popc(mlo); c2 += __popc(mhi);
                }
                {
                    const bool pb = (VAR == 3) ? false : (key <= t0 + 1 + 2 * hh) && (ub[i] > tau_b) && (VAR != 2 || (hh ? c3 : c1) < 440);
                    const unsigned long long m = __ballot(pb); const unsigned mlo = (unsigned)m, mhi = (unsigned)(m >> 32);
                    const unsigned off = hh ? __builtin_amdgcn_mbcnt_hi(mhi, 0u) : __builtin_amdgcn_mbcnt_lo(mlo, 0u);
                    if (pb) wb[(hh ? 1536 + c3 : 512 + c1) + off] = (u32x2){ub[i], (unsigned)key};
                    c1 += __popc(mlo); c3 += __popc(mhi);
                }
            }
        }
        { unsigned t;
          if (c0 > 256) c0 = topk_compact<true>(wb, c0, lane, t);
          if (c1 > 256) c1 = topk_compact<true>(wb + 512, c1, lane, t);
          if (c2 > 256) c2 = topk_compact<true>(wb + 1024, c2, lane, t);
          if (c3 > 256) c3 = topk_compact<true>(wb + 1536, c3, lane, t); }
#pragma unroll
        for (int q = 0; q < 4; ++q) {
            const int n = (q == 0) ? c0 : (q == 1) ? c1 : (q == 2) ? c2 : c3;
            unsigned k4[4];
#pragma unroll
            for (int i = 0; i < 4; ++i) { const int pz = 4 * lane + i; k4[i] = (pz < n) ? wb[q * 512 + pz].y : 0u; }
            *(u32x2*)(idxo + (size_t)(rb + t0 + q) * 256 + 4 * lane) = (u32x2){k4[0] | (k4[1] << 16), k4[2] | (k4[3] << 16)};
        }
    }
}

__device__ __forceinline__ void topk_phase(Frame& F, unsigned* qhead) { topk_phase_t<0>(F, qhead); }

__device__ __forceinline__ unsigned offb(unsigned row, unsigned ch) { return 256u * row + 16u * (ch ^ (((row & 3u) << 2) | ((row >> 2) & 3u))); }
__device__ __forceinline__ bf16x8 tr_read2(unsigned a0, unsigned a1) {
    u32x2 r0, r1;
    asm volatile("ds_read_b64_tr_b16 %0, %2\n\tds_read_b64_tr_b16 %1, %3\n\ts_waitcnt lgkmcnt(0)" : "=&v"(r0), "=&v"(r1) : "v"(a0), "v"(a1) : "memory");
    const u32x4 v = (u32x4){r0.x, r0.y, r1.x, r1.y};
    return __builtin_bit_cast(bf16x8, v);
}
__device__ __forceinline__ float xrow_max(float x) {
    auto s = __builtin_amdgcn_permlane16_swap(__float_as_uint(x), __float_as_uint(x), false, false); const unsigned s0 = s[0], s1 = s[1];
    x = fmaxf(__uint_as_float(s0), __uint_as_float(s1));
    auto t = __builtin_amdgcn_permlane32_swap(__float_as_uint(x), __float_as_uint(x), false, false); const unsigned t0 = t[0], t1 = t[1];
    return fmaxf(__uint_as_float(t0), __uint_as_float(t1));
}
__device__ __forceinline__ float xrow_sum(float x) {
    auto s = __builtin_amdgcn_permlane16_swap(__float_as_uint(x), __float_as_uint(x), false, false); const unsigned s0 = s[0], s1 = s[1];
    x = __uint_as_float(s0) + __uint_as_float(s1);
    auto t = __builtin_amdgcn_permlane32_swap(__float_as_uint(x), __float_as_uint(x), false, false); const unsigned t0 = t[0], t1 = t[1];
    return __uint_as_float(t0) + __uint_as_float(t1);
}
__device__ __forceinline__ void tr_read8(const unsigned (&a)[8], bf16x8 (&o)[4]) {
    u32x2 r0, r1, r2, r3, r4, r5, r6, r7;
    asm volatile("ds_read_b64_tr_b16 %0, %8\n\tds_read_b64_tr_b16 %1, %9\n\tds_read_b64_tr_b16 %2, %10\n\tds_read_b64_tr_b16 %3, %11\n\t"
                 "ds_read_b64_tr_b16 %4, %12\n\tds_read_b64_tr_b16 %5, %13\n\tds_read_b64_tr_b16 %6, %14\n\tds_read_b64_tr_b16 %7, %15\n\ts_waitcnt lgkmcnt(0)"
                 : "=&v"(r0), "=&v"(r1), "=&v"(r2), "=&v"(r3), "=&v"(r4), "=&v"(r5), "=&v"(r6), "=&v"(r7)
                 : "v"(a[0]), "v"(a[1]), "v"(a[2]), "v"(a[3]), "v"(a[4]), "v"(a[5]), "v"(a[6]), "v"(a[7]) : "memory");
    o[0] = __builtin_bit_cast(bf16x8, (u32x4){r0.x, r0.y, r1.x, r1.y}); o[1] = __builtin_bit_cast(bf16x8, (u32x4){r2.x, r2.y, r3.x, r3.y});
    o[2] = __builtin_bit_cast(bf16x8, (u32x4){r4.x, r4.y, r5.x, r5.y}); o[3] = __builtin_bit_cast(bf16x8, (u32x4){r6.x, r6.y, r7.x, r7.y});
}
template <int VAR>
__device__ __forceinline__ void attn_phase_t(Frame& F) {
    bf16_t* proj = (bf16_t*)(F.ws + WS_PROJ); const bf16_t* ckv = (const bf16_t*)(F.ws + WS_CKV); const unsigned short* idxg = (const unsigned short*)(F.ws + WS_IDX);
    const float* relb = F.ap->in[I_RELB];
    LAS float* biasl = (LAS float*)(F.lds + LDS_AUX);
    LAS unsigned short* idxs = (LAS unsigned short*)(F.lds + LDS_AUX + 4608 + F.wave * 512);
    LAS unsigned char* tile = F.lds + F.wave * 16384;
    const unsigned tile_addr = (unsigned)(uintptr_t)tile;
    for (int i = F.tid; i < 129 * 8; i += 512) { const int d = i >> 3, h = i & 7; int bk = d;
        if (d >= 16) { bk = 16 + (int)(logf((float)d * (1.f / 16.f)) / logf(8.f) * 16.f); if (bk > 31) bk = 31; }
        biasl[i] = relb[bk * 8 + h]; }
    __syncthreads();
    const int lane = F.lane, g4 = lane >> 4, c15 = lane & 15, qq = c15 >> 2, pp = lane & 3;
    const bool hv = c15 < 8;
    LAS unsigned short* idxb = (LAS unsigned short*)(F.lds + LDS_AUX + 4608 + F.wave * 1024);
    u32x4 nx[4][4]; bf16x8 bq[4];
    {
        const int r = F.gw; const int lb = r >> 13;
        *(LAS u32x2*)(idxb + 4 * lane) = *(const u32x2*)(idxg + (size_t)r * 256 + 4 * lane);
#pragma unroll
        for (int ks = 0; ks < 4; ++ks) { u32x4 v = (u32x4){0u, 0u, 0u, 0u}; if (hv) v = *(const u32x4*)(proj + (size_t)r * NP + C_QL + c15 * 128 + 32 * ks + 8 * g4); bq[ks] = __builtin_bit_cast(bf16x8, v); }
        LDS_WAIT();
        const bf16_t* cbase = ckv + (size_t)lb * SEQ * 128 + 8 * g4;
#pragma unroll
        for (int grp = 0; grp < 4; ++grp) { const int key = idxb[16 * grp + c15]; const bf16_t* kr = cbase + (size_t)key * 128;
#pragma unroll
            for (int ks = 0; ks < 4; ++ks) nx[grp][ks] = *(const u32x4*)(kr + 32 * ks); }
    }
    int it = 0;
    for (int r = F.gw; r < MH; r += F.NGW, ++it) {
        const int t = r & (SEQ - 1), lb = r >> 13;
        const int nsel = (t + 1 < 256) ? t + 1 : 256;
        LAS unsigned short* idxs = idxb + (it & 1) * 256; LAS unsigned short* idxn = idxb + ((it & 1) ^ 1) * 256;
        const int rn = r + F.NGW; const bool have_next = rn < MH;
        u32x2 idn = (u32x2){0u, 0u}; bf16x8 bqn[4];
        if (have_next) { idn = *(const u32x2*)(idxg + (size_t)rn * 256 + 4 * lane);
#pragma unroll
            for (int ks = 0; ks < 4; ++ks) { u32x4 v = (u32x4){0u, 0u, 0u, 0u}; if (hv) v = *(const u32x4*)(proj + (size_t)rn * NP + C_QL + c15 * 128 + 32 * ks + 8 * g4); bqn[ks] = __builtin_bit_cast(bf16x8, v); } }
        else {
#pragma unroll
            for (int ks = 0; ks < 4; ++ks) bqn[ks] = bq[ks]; }
        float mrun = -1e30f, lsum = 0.f;
        f32x4 O[8];
#pragma unroll
        for (int c = 0; c < 8; ++c) O[c] = (f32x4){0.f, 0.f, 0.f, 0.f};
        const int nch = (nsel + 63) >> 6;
        const bf16_t* cbase = ckv + (size_t)lb * SEQ * 128 + 8 * g4;
        for (int cch = 0; cch < nch; ++cch) {
            float bs[4][4];
#pragma unroll
            for (int grp = 0; grp < 4; ++grp) {
                const u32x2 k4 = *(const LAS u32x2*)(idxs + 64 * cch + 16 * grp + 4 * g4);
                const int kk[4] = {(int)(k4.x & 0xffffu), (int)(k4.x >> 16), (int)(k4.y & 0xffffu), (int)(k4.y >> 16)};
#pragma unroll
                for (int j = 0; j < 4; ++j) { const int pz = 64 * cch + 16 * grp + 4 * g4 + j; int d = t - kk[j]; d = d < 0 ? 0 : (d > 128 ? 128 : d);
                    const float bv = biasl[d * 8 + (c15 & 7)]; bs[grp][j] = (pz < nsel) ? bv : -1e30f; }
            }
            f32x4 L[4];
#pragma unroll
            for (int grp = 0; grp < 4; ++grp) {
                f32x4 a = (f32x4){0.f, 0.f, 0.f, 0.f};
#pragma unroll
                for (int ks = 0; ks < 4; ++ks) { *(LAS u32x4*)(tile + offb(16 * grp + c15, 4 * ks + g4)) = nx[grp][ks]; a = __builtin_amdgcn_mfma_f32_16x16x32_bf16(__builtin_bit_cast(bf16x8, nx[grp][ks]), bq[ks], a, 0, 0, 0); }
                L[grp] = a;
            }
            if (VAR == 4 && cch + 1 < nch) { } else if (cch + 1 < nch) {
#pragma unroll
                for (int grp = 0; grp < 4; ++grp) { const int key = idxs[64 * (cch + 1) + 16 * grp + c15]; const bf16_t* kr = cbase + (size_t)key * 128;
#pragma unroll
                    for (int ks = 0; ks < 4; ++ks) nx[grp][ks] = *(const u32x4*)(kr + 32 * ks); }
            } else if (have_next) {
                *(LAS u32x2*)(idxn + 4 * lane) = idn; LDS_WAIT();
                const bf16_t* cbn = ckv + (size_t)(rn >> 13) * SEQ * 128 + 8 * g4;
#pragma unroll
                for (int grp = 0; grp < 4; ++grp) { const int key = idxn[16 * grp + c15]; const bf16_t* kr = cbn + (size_t)key * 128;
#pragma unroll
                    for (int ks = 0; ks < 4; ++ks) if (VAR != 4) nx[grp][ks] = *(const u32x4*)(kr + 32 * ks); }
            }
            float cmax = -1e30f;
#pragma unroll
            for (int grp = 0; grp < 4; ++grp)
#pragma unroll
                for (int j = 0; j < 4; ++j) { float lg = L[grp][j] * 0.125f + bs[grp][j]; lg = (bs[grp][j] > -1e29f) ? lg : -1e30f; L[grp][j] = lg; cmax = fmaxf(cmax, lg); }
            cmax = xrow_max(cmax);
            const float mnew = fmaxf(mrun, cmax), alpha = __expf(mrun - mnew);
            float ps = 0.f;
#pragma unroll
            for (int grp = 0; grp < 4; ++grp)
#pragma unroll
                for (int j = 0; j < 4; ++j) { float pv = __expf(L[grp][j] - mnew); pv = (hv && L[grp][j] > -1e29f) ? pv : 0.f; L[grp][j] = pv; ps += pv; }
            lsum = lsum * alpha + ps; mrun = mnew;
            bf16x8 pa[2];
#pragma unroll
            for (int kk2 = 0; kk2 < 2; ++kk2) { const u32x4 v = (u32x4){cvt_pk_bf16(L[2 * kk2][0], L[2 * kk2][1]), cvt_pk_bf16(L[2 * kk2][2], L[2 * kk2][3]), cvt_pk_bf16(L[2 * kk2 + 1][0], L[2 * kk2 + 1][1]), cvt_pk_bf16(L[2 * kk2 + 1][2], L[2 * kk2 + 1][3])}; pa[kk2] = __builtin_bit_cast(bf16x8, v); }
            float ar[4];
#pragma unroll
            for (int j = 0; j < 4; ++j) { const float lo = __uint_as_float(__builtin_amdgcn_readlane(__float_as_uint(alpha), j)), hi = __uint_as_float(__builtin_amdgcn_readlane(__float_as_uint(alpha), 4 + j)); ar[j] = (g4 & 1) ? hi : lo; }
#pragma unroll
            for (int c = 0; c < 8; ++c)
#pragma unroll
                for (int j = 0; j < 4; ++j) O[c][j] *= ar[j];
            LDS_WAIT();
#pragma unroll
            for (int kk2 = 0; kk2 < 2; ++kk2) {
                unsigned ad0[8], ad1[8]; bf16x8 bv0[4], bv1[4];
#pragma unroll
                for (int i = 0; i < 4; ++i) { ad0[2 * i] = tile_addr + offb(32 * kk2 + 4 * g4 + qq, 2 * i + (pp >> 1)) + 8 * (pp & 1); ad0[2 * i + 1] = tile_addr + offb(32 * kk2 + 16 + 4 * g4 + qq, 2 * i + (pp >> 1)) + 8 * (pp & 1);
                    ad1[2 * i] = tile_addr + offb(32 * kk2 + 4 * g4 + qq, 2 * (4 + i) + (pp >> 1)) + 8 * (pp & 1); ad1[2 * i + 1] = tile_addr + offb(32 * kk2 + 16 + 4 * g4 + qq, 2 * (4 + i) + (pp >> 1)) + 8 * (pp & 1); }
                if (VAR != 2) { tr_read8(ad0, bv0); tr_read8(ad1, bv1); } else { for (int i = 0; i < 4; ++i) { bv0[i] = pa[kk2]; bv1[i] = pa[kk2]; } }
#pragma unroll
                for (int i = 0; i < 4; ++i) { O[i] = __builtin_amdgcn_mfma_f32_16x16x32_bf16(pa[kk2], bv0[i], O[i], 0, 0, 0); O[4 + i] = __builtin_amdgcn_mfma_f32_16x16x32_bf16(pa[kk2], bv1[i], O[4 + i], 0, 0, 0); }
            }
        }
        lsum = xrow_sum(lsum);
        const float inv = __builtin_amdgcn_rcpf(lsum);
        float ir[4];
#pragma unroll
        for (int j = 0; j < 4; ++j) { const float lo = __uint_as_float(__builtin_amdgcn_readlane(__float_as_uint(inv), j)), hi = __uint_as_float(__builtin_amdgcn_readlane(__float_as_uint(inv), 4 + j)); ir[j] = (g4 & 1) ? hi : lo; }
        LAS bf16_t* ost = (LAS bf16_t*)tile;
        if (g4 < 2) {
#pragma unroll
            for (int c = 0; c < 8; ++c)
#pragma unroll
                for (int j = 0; j < 4; ++j) ost[(4 * g4 + j) * 128 + 16 * c + c15] = (bf16_t)f2bf(EXP_ZERO_DSA ? 0.f : O[c][j] * ir[j]);
        }
        LDS_WAIT();
        {
            bf16_t* dst = VAR ? (bf16_t*)(F.ws + 1010 * MiB) + (size_t)(r & 4095) * 1024 : (bf16_t*)(F.ws + WS_OL) + (size_t)r * 1024;
            const u32x4 o0 = *(const LAS u32x4*)(ost + 8 * lane), o1 = *(const LAS u32x4*)(ost + 512 + 8 * lane);
            *(u32x4*)(dst + 8 * lane) = o0; *(u32x4*)(dst + 512 + 8 * lane) = o1;
        }
        LDS_WAIT();
#pragma unroll
        for (int ks = 0; ks < 4; ++ks) bq[ks] = bqn[ks];
    }
}
__device__ __forceinline__ void attn_phase(Frame& F) { attn_phase_t<0>(F); }
__device__ __forceinline__ void prologue(Frame& F) {
    int base = 0;
    for (int l = 0; l < DEPTH; ++l) {
        unsigned char* wm = F.ws + WS_WMIX + (size_t)l * WMIX_LAYER;
        { ValInProj v{F.ap->in[I_WIN] + (size_t)l * D * DIN, F.ap->in[I_WUK] + (size_t)l * 8 * 64 * 128}; convert_matrix(F, v, D, NP, (bf16_t*)(wm + WM_IN), base); }
        { ValPlain v{F.ap->in[I_WBA] + (size_t)l * 512 * D, D}; convert_matrix(F, v, 512, D, (bf16_t*)(wm + WM_A), base); }
        { ValOB v{F.ap->in[I_WUV] + (size_t)l * 8 * 128 * 64, F.ap->in[I_WBB] + (size_t)l * 512 * D}; convert_matrix(F, v, D, D, (bf16_t*)(wm + WM_OB), base); }
        { ValPlain v{F.ap->in[I_WOUT] + (size_t)l * D * D, D}; convert_matrix(F, v, D, D, (bf16_t*)(wm + WM_OUT), base); }
    }
    bf16_t* xb = (bf16_t*)(F.ws + WS_XB);
    for (int r = F.gw; r < BATCH * SEQ; r += F.NGW) {
        const float* xr = F.ap->in[I_X] + (size_t)r * D + 4 * F.lane;
#pragma unroll
        for (int j = 0; j < 4; ++j) { const f32x4 v = *(const f32x4*)(xr + 256 * j);
            u32x2 w; w.x = cvt_pk_bf16(v[0], v[1]); w.y = cvt_pk_bf16(v[2], v[3]); *(u32x2*)(xb + (size_t)r * D + 4 * F.lane + 256 * j) = w; }
    }
}
__device__ __forceinline__ void ffn_weights(Frame& F, int l) {
    int base = 0; const int j = l >> 1;
    if ((l & 1) == 0) {
        { ValGU v{F.ap->in[I_DWG] + (size_t)j * D * DFF, F.ap->in[I_DWU] + (size_t)j * D * DFF, DFF}; convert_matrix64(F, v, D, 2 * DFF, (bf16_t*)(F.ws + WS_WFFN), base); }
        { ValPlain v{F.ap->in[I_DWD] + (size_t)j * DFF * D, D}; convert_matrix64(F, v, DFF, D, (bf16_t*)(F.ws + WS_WFFN + WF_D_OFF), base); }
    } else {
        for (int e = 0; e < NEXP; ++e) {
            { ValGU v{F.ap->in[I_EWG] + (size_t)(j * NEXP + e) * D * DFE, F.ap->in[I_EWU] + (size_t)(j * NEXP + e) * D * DFE, DFE}; convert_matrix64(F, v, D, 2 * DFE, (bf16_t*)(F.ws + WS_WFFN + (size_t)e * WF_GU_E), base); }
            { ValPlain v{F.ap->in[I_EWD] + (size_t)(j * NEXP + e) * DFE * D, D}; convert_matrix64(F, v, DFE, D, (bf16_t*)(F.ws + WS_WFFN + WF_D_OFF + (size_t)e * WF_D_E), base); }
        }
    }
}

enum { K_PRO = 0, K_FW, K_A, K_B, K_C, K_D, K_E, K_F, K_G, K_H1, K_H2, K_H3, K_H4, K_N };
template <int KIND>
__device__ __forceinline__ void run_phase(Frame& F0, int l, int hf) {
    Frame F = F0;
    { int t = F0.tid; asm volatile("" : "+v"(t)); F.tid = t; F.lane = t & 63; F.wave = __builtin_amdgcn_readfirstlane(t >> 6); }
    int cb = blockIdx.x; asm volatile("" : "+s"(cb)); asm volatile("" : "+s"(l)); asm volatile("" : "+s"(hf));
    { CArgs a = F0.ap; asm volatile("" : "+s"(a)); F.ap = a; F.ws = a->ws; F.out = a->out; }
    F.vcu = cb; F.gw = cb * 8 + F.wave;
    LAS unsigned char* L = F.lds;
    const int G = F.G;
    bf16_t* proj = (bf16_t*)(F.ws + WS_PROJ);
    const unsigned char* wm = F.ws + WS_WMIX + (size_t)l * WMIX_LAYER;
    const bool whole = (hf == 2);
    const int mrows = whole ? 2 * MH : MH;
    const bf16_t* xbh = (const bf16_t*)(F.ws + WS_XB) + (size_t)(whole ? 0 : hf) * MH * D;
    float* outh = F.out + (size_t)(whole ? 0 : hf) * MH * D;
    const bool moe = (l & 1) != 0;
    const unsigned* meta = (const unsigned*)(F.ws + WS_MISC + MS_META);
    if constexpr (KIND == K_PRO) prologue(F);
    if constexpr (KIND == K_FW) { }
    if constexpr (KIND == K_A) { pg8::Gemm g{xbh, (const bf16_t*)(wm + WM_IN), D, D, D}; pg8::Order S; S.init(MH / 256, NP / 256, G, cb, g, nullptr, 0, WGM_A);
        pg8::EpiInProj E{proj, (float*)(F.ws + WS_SIDE), (bf16_t*)(F.ws + WS_MG), (bf16_t*)(F.ws + WS_GB)}; pg8::gemm_phase(L, g, S, E, F.tid); }
    if constexpr (KIND == K_B) { mlstm_local(F, l); ckv_pass(F, l); if (hf == 0) ffn_weights(F, l); }
    if constexpr (KIND == K_C) {
#if defined(TIME_SUB) && TIME_SUB >= 3 && TIME_SUB <= 5
        topk_phase(F, (unsigned*)(F.ws + WS_CTL) + 8192 + 64 * (2 * l + hf));
        __syncthreads(); const unsigned long long ta_ = __builtin_amdgcn_s_memrealtime();
        mlstm_scan(F);
        __syncthreads(); const unsigned long long tb_ = __builtin_amdgcn_s_memrealtime();
        if (F.tid == 0) { volatile LAS unsigned long long* tacc = (volatile LAS unsigned long long*)(F.lds + LDS_CTLW + 128); tacc[0] += (tb_ - ta_); }
#elif defined(TIME_SUB) && TIME_SUB >= 11 && TIME_SUB <= 13
        topk_phase(F, (unsigned*)(F.ws + WS_CTL) + 8192 + 64 * (2 * l + hf)); __syncthreads(); mlstm_scan(F);
        __syncthreads(); const unsigned long long ta_ = __builtin_amdgcn_s_memrealtime();
        topk_phase_t<TIME_SUB - 10>(F, (unsigned*)(F.ws + WS_CTL) + 16384 + 64 * (2 * l + hf));
        __syncthreads(); const unsigned long long tb_ = __builtin_amdgcn_s_memrealtime();
        if (F.tid == 0) { volatile LAS unsigned long long* tacc = (volatile LAS unsigned long long*)(F.lds + LDS_CTLW + 128); tacc[0] += (tb_ - ta_); }
#elif defined(TIME_SUB) && TIME_SUB == 6
        mlstm_scan(F); __syncthreads(); topk_phase(F, (unsigned*)(F.ws + WS_CTL) + 8192 + 64 * (2 * l + hf));
        for (int rep = 0; rep < 2; ++rep) {
            __syncthreads(); const unsigned long long ta_ = __builtin_amdgcn_s_memrealtime();
            mlstm_scan_t<true>(F);
            __syncthreads(); const unsigned long long tb_ = __builtin_amdgcn_s_memrealtime();
            if (F.tid == 0 && rep == TIME_REP) { volatile LAS unsigned long long* tacc = (volatile LAS unsigned long long*)(F.lds + LDS_CTLW + 128); tacc[0] += (tb_ - ta_); }
        }
#else
        topk_phase(F, (unsigned*)(F.ws + WS_CTL) + 8192 + 64 * (2 * l + hf)); __syncthreads(); mlstm_scan(F);
#endif
    }
    if constexpr (KIND == K_D) {
#if defined(TIME_SUB) && TIME_SUB && TIME_SUB <= 2
        const unsigned long long ta_ = __builtin_amdgcn_s_memrealtime();
        mlstm_out(F, l);
        __syncthreads(); const unsigned long long tb_ = __builtin_amdgcn_s_memrealtime();
        attn_phase(F);
        __syncthreads(); const unsigned long long tc_ = __builtin_amdgcn_s_memrealtime();
        if (F.tid == 0) { volatile LAS unsigned long long* tacc = (volatile LAS unsigned long long*)(F.lds + LDS_CTLW + 128); tacc[0] += (TIME_SUB == 1) ? (tb_ - ta_) : (tc_ - tb_); }
#elif defined(TIME_SUB) && TIME_SUB >= 7
        mlstm_out(F, l); attn_phase(F);
        __syncthreads(); const unsigned long long ta_ = __builtin_amdgcn_s_memrealtime();
        attn_phase_t<TIME_SUB - 6>(F);
        __syncthreads(); const unsigned long long tb_ = __builtin_amdgcn_s_memrealtime();
        if (F.tid == 0) { volatile LAS unsigned long long* tacc = (volatile LAS unsigned long long*)(F.lds + LDS_CTLW + 128); tacc[0] += (tb_ - ta_); }
#else
        mlstm_out(F, l); attn_phase(F);
#endif
    }
    if constexpr (KIND == K_E) {
        { pg8::Gemm g{(const bf16_t*)(F.ws + WS_YA), (const bf16_t*)(wm + WM_A), 512, 512, 512}; pg8::Order S; S.init(MH / 256, D / 256, G, cb, g); pg8::EpiMerge<0> E{(bf16_t*)(F.ws + WS_MG), (const bf16_t*)(F.ws + WS_GB)}; pg8::gemm_phase(L, g, S, E, F.tid); }
        { pg8::Gemm g{(const bf16_t*)(F.ws + WS_OL), (const bf16_t*)(wm + WM_OB), D, D, D}; pg8::Order S; S.init(MH / 256, D / 256, G, cb, g); pg8::EpiMerge<1> E{(bf16_t*)(F.ws + WS_MG), (const bf16_t*)(F.ws + WS_GB)}; pg8::gemm_phase(L, g, S, E, F.tid); }
    }
    if constexpr (KIND == K_F) { pg8::Gemm g{(const bf16_t*)(F.ws + WS_MG), (const bf16_t*)(wm + WM_OUT), D, D, D}; pg8::Order S; S.init(MH / 256, D / 256, G, cb, g); pg8::EpiResid E{xbh, (bf16_t*)(F.ws + WS_PRE)}; pg8::gemm_phase(L, g, S, E, F.tid); }
    if constexpr (KIND == K_G) { if (moe) ln_pass<0, true>(F, l, 0, hf, nullptr, nullptr); else ln_pass<0, false>(F, l, 0, hf, nullptr, nullptr); }
    if constexpr (KIND == K_H1) { if (moe) moe_scatter(F, hf); }
    if constexpr (KIND == K_H2) {
        const int nblk = moe ? (int)meta[0] : mrows / 256;
        pg8::Gemm g{moe ? (const bf16_t*)(F.ws + WS_XS) : xbh, (const bf16_t*)(F.ws + WS_WFFN), D, D, D}; pg8::Order S;
        S.init(nblk, moe ? (2 * DFE) / 256 : (2 * DFF) / 256, G, cb, g, moe ? meta + 16 : nullptr, WF_GU_E, WGM_F);
        pg8::EpiSwiglu E{moe ? (bf16_t*)(F.ws + WS_HM) : (bf16_t*)(F.ws + WS_HD), moe ? DFE : DFF}; pg8::gemm_phase(L, g, S, E, F.tid);
    }
    if constexpr (KIND == K_H3) {
        if (moe) { const int nblk = (int)meta[0]; pg8::Gemm g{(const bf16_t*)(F.ws + WS_HM), (const bf16_t*)(F.ws + WS_WFFN + WF_D_OFF), DFE, DFE, DFE}; pg8::Order S;
            S.init(nblk, D / 256, G, cb, g, meta + 16, WF_D_E, WGM_F); pg8::EpiMoeDown E{(bf16_t*)(F.ws + WS_XS), (const float*)(F.ws + WS_MISC + MS_RG)}; pg8::gemm_phase(L, g, S, E, F.tid); }
        else { pg8::Gemm g{(const bf16_t*)(F.ws + WS_HD), (const bf16_t*)(F.ws + WS_WFFN + WF_D_OFF), DFF, DFF, DFF}; pg8::Order S; S.init(mrows / 256, D / 256, G, cb, g, nullptr, 0, WGM_F);
            pg8::EpiResid E{xbh, (bf16_t*)(F.ws + (whole ? WS_PRE2 : WS_PRE))}; pg8::gemm_phase(L, g, S, E, F.tid); }
    }
    if constexpr (KIND == K_H4) { if (moe) ln_pass<1, false>(F, l, 1, hf, (const bf16_t*)(F.ws + WS_XS), (const unsigned*)(F.ws + WS_MISC + MS_TD)); else ln_pass<0, false>(F, l, 1, hf, nullptr, nullptr); }
}
__device__ __forceinline__ void frame_init(Frame& F, const Args& args, unsigned char* lds_raw) {
    F.lds = (LAS unsigned char*)lds_raw;
    F.tid = threadIdx.x; F.lane = F.tid & 63; F.wave = __builtin_amdgcn_readfirstlane(F.tid >> 6);
    F.G = gridDim.x; F.vcu = blockIdx.x; F.gw = blockIdx.x * 8 + F.wave; F.NGW = F.G * 8;
    F.ap = (CArgs)__builtin_amdgcn_kernarg_segment_ptr(); F.out = F.ap->out; F.ws = F.ap->ws;
}
template <int KIND> __global__ void __launch_bounds__(512, 2) k_one(Args args) {
    extern __shared__ __attribute__((aligned(16))) unsigned char lds_raw[];
    Frame F; frame_init(F, args, lds_raw);
    run_phase<KIND>(F, args.ph_lo, args.ph_hi);
}
#if MK_ONE_LAUNCH
#ifndef TIME_SEL
#define TIME_SEL 0
#endif
#if TIME_SEL
#define PH(KIND, L, HF, BAR) do { const unsigned long long t0_ = __builtin_amdgcn_s_memrealtime(); run_phase<KIND>(F, L, HF); asm volatile("s_waitcnt vmcnt(0)" ::: "memory"); __syncthreads(); const unsigned long long t1_ = __builtin_amdgcn_s_memrealtime(); \
    if (BAR) xcd_barrier(bar); const unsigned long long t2_ = __builtin_amdgcn_s_memrealtime(); if (F.tid == 0) { if ((TIME_SEL >> KIND) & 1) tacc[0] += t1_ - t0_; if ((TIME_SEL >> 15) & 1) tacc[0] += t2_ - t1_; } } while (0)
#else
#define PH(KIND, L, HF, BAR) do { run_phase<KIND>(F, L, HF); if (BAR) xcd_barrier(bar); } while (0)
#endif
template <int L, int HF> __device__ __forceinline__ void half_program(Frame& F, const XcdBarrier& bar, volatile LAS unsigned long long* tacc) {
    PH(K_A, L, HF, true); PH(K_B, L, HF, true); PH(K_C, L, HF, true); PH(K_D, L, HF, true); PH(K_E, L, HF, true); PH(K_F, L, HF, true); PH(K_G, L, HF, true);
    if constexpr ((L & 1) != 0) { PH(K_H1, L, HF, true); }
    if constexpr ((L & 1) != 0) {
        PH(K_H2, L, HF, true); PH(K_H3, L, HF, true);
        PH(K_H4, L, HF, !(L == DEPTH - 1 && HF == NHALF - 1));
    }
}
template <int L> __device__ __forceinline__ void layer_program(Frame& F, const XcdBarrier& bar, volatile LAS unsigned long long* tacc) {
#if defined(HF_LOOP) && HF_LOOP
    for (int hf = 0; hf < NHALF; ++hf) {
        PH(K_A, L, hf, true); PH(K_B, L, hf, true); PH(K_C, L, hf, true); PH(K_D, L, hf, true); PH(K_E, L, hf, true); PH(K_F, L, hf, true); PH(K_G, L, hf, true);
        if constexpr ((L & 1) != 0) { PH(K_H1, L, hf, true); }
        PH(K_H2, L, hf, true); PH(K_H3, L, hf, true);
        PH(K_H4, L, hf, !(L == DEPTH - 1) || hf == 0);
    }
#else
    half_program<L, 0>(F, bar, tacc);
    half_program<L, 1>(F, bar, tacc);
    if constexpr ((L & 1) == 0) { PH(K_H2, L, 2, true); PH(K_H3, L, 2, true); PH(K_H4, L, 2, true); }
#endif
}
__global__ void __launch_bounds__(512, 2) fwd(Args args) {
    extern __shared__ __attribute__((aligned(16))) unsigned char lds_raw[];
    Frame F; frame_init(F, args, lds_raw);
    volatile LAS unsigned* ctlw = (volatile LAS unsigned*)(F.lds + LDS_CTLW);
    volatile LAS unsigned long long* tacc = (volatile LAS unsigned long long*)(F.lds + LDS_CTLW + 128);
    if (F.tid < 64) ctlw[F.tid] = 0u;
    __syncthreads();
    XcdBarrier bar = xcd_barrier_post((unsigned*)(F.ws + WS_CTL) + CW_BAR, ctlw + 8);
    PH(K_PRO, 0, 0, true);
    layer_program<0>(F, bar, tacc); layer_program<1>(F, bar, tacc); layer_program<2>(F, bar, tacc); layer_program<3>(F, bar, tacc);
#if TIME_SEL || (defined(TIME_SUB) && TIME_SUB)
    if (F.tid == 0) { const unsigned long long d = tacc[0], t0 = __builtin_amdgcn_s_memrealtime(); while (__builtin_amdgcn_s_memrealtime() - t0 < d) __builtin_amdgcn_s_sleep(8); }
#endif
}
#undef PH
#endif

template <int KIND> static void launch_one(int grid, hipStream_t stream, Args a, int l, int hf) {
    static bool attr = false;
    if (!attr) { (void)hipFuncSetAttribute((const void*)k_one<KIND>, hipFuncAttributeMaxDynamicSharedMemorySize, LDS_BYTES); attr = true; }
    a.ph_lo = l; a.ph_hi = hf;
    hipLaunchKernelGGL(k_one<KIND>, dim3(grid), dim3(512), LDS_BYTES, stream, a);
}
extern "C" void kernel_launch(void* const* d_in, const int* in_sizes, int n_in, void* d_out, int out_size, void* d_ws, size_t ws_size, hipStream_t stream) {
    static int grid = 0;
    if (grid == 0) {
        if (n_in != 21 || out_size != BATCH * SEQ * D || ws_size < WS_END) { fprintf(stderr, "kernel_launch: unexpected problem shape (n_in %d, out %d, ws %zu)\n", n_in, out_size, ws_size); grid = -1; return; }
        int dev = 0, cus = 0;
        if (hipGetDevice(&dev) != hipSuccess || hipDeviceGetAttribute(&cus, hipDeviceAttributeMultiprocessorCount, dev) != hipSuccess) { grid = -1; return; }
#if MK_ONE_LAUNCH
        int per_cu = 0;
        if (hipFuncSetAttribute((const void*)fwd, hipFuncAttributeMaxDynamicSharedMemorySize, LDS_BYTES) != hipSuccess) { fprintf(stderr, "kernel_launch: hipFuncSetAttribute failed\n"); grid = -1; return; }
        if (hipOccupancyMaxActiveBlocksPerMultiprocessor(&per_cu, (const void*)fwd, 512, LDS_BYTES) != hipSuccess || per_cu < 1) fprintf(stderr, "kernel_launch: occupancy query reports %d\n", per_cu);
        (void)hipGetLastError();
#endif
        grid = cus;
    }
    if (grid < 0) return;
    (void)in_sizes;
    Args a{};
    for (int i = 0; i < 21; ++i) a.in[i] = (const float*)d_in[i];
    a.out = (float*)d_out; a.ws = (unsigned char*)d_ws;
#if MK_ONE_LAUNCH
    if (hipMemsetAsync((char*)d_ws + WS_CTL, 0, CTL_BYTES, stream) != hipSuccess) return;
    hipLaunchKernelGGL(fwd, dim3(grid), dim3(512), LDS_BYTES, stream, a);
#else
    if (hipMemsetAsync((char*)d_ws + WS_CTL, 0, CTL_BYTES, stream) != hipSuccess) return;
    launch_one<K_PRO>(grid, stream, a, 0, 0);
    for (int l = 0; l < DEPTH; ++l) {
        for (int hf = 0; hf < NHALF; ++hf) {
            launch_one<K_A>(grid, stream, a, l, hf); launch_one<K_B>(grid, stream, a, l, hf); launch_one<K_C>(grid, stream, a, l, hf); launch_one<K_D>(grid, stream, a, l, hf);
            launch_one<K_E>(grid, stream, a, l, hf); launch_one<K_F>(grid, stream, a, l, hf); launch_one<K_G>(grid, stream, a, l, hf);
            if (l & 1) { launch_one<K_H1>(grid, stream, a, l, hf); launch_one<K_H2>(grid, stream, a, l, hf); launch_one<K_H3>(grid, stream, a, l, hf); launch_one<K_H4>(grid, stream, a, l, hf); }
        }
        if (!(l & 1)) { launch_one<K_H2>(grid, stream, a, l, 2); launch_one<K_H3>(grid, stream, a, l, 2); launch_one<K_H4>(grid, stream, a, l, 2); }
    }
#endif
}
```
